# Optimizing an MI355X kernel written in HIP

```python
import functools
import jax, jax.numpy as jnp
from jax import lax
import numpy as np

D_MODEL = 1024
BATCH = 16
SEQ = 256
DEPTH = 1
DEC_BATCH = 8
DEC_SEQ = 1024
PAST_LEN = 256

GRID_W = 64
N_HEADS = 8
HEAD_DIM = 64
D_ATTN = N_HEADS * HEAD_DIM
WIN_H = 8
WIN_W = 16
D_LRU = 1024
LRU_BLOCKS = 16
LRU_BLOCK = D_LRU // LRU_BLOCKS
CONV_W = 4
LRU_C = 8.0
D_FF = 2816
N_MOD = 9
IN_WIDTH = 3 * D_ATTN + 2 * D_LRU + 2 * D_MODEL
EPS = 1e-6
NEG_INF = -1e30

kernel_name = 'hybrid_na_rglru_diffusion_step'


def rmsnorm(x, g):
    x32 = x.astype(jnp.float32)
    y = x32 * lax.rsqrt(jnp.mean(x32 * x32, axis=-1, keepdims=True) + EPS)
    return (y * g.astype(jnp.float32)).astype(x.dtype)


def modulate(xn, shift, scale):
    return xn * (1 + scale[:, None, :]) + shift[:, None, :]


def swiglu(x, w_in, w_out):
    g, u = jnp.split(x @ w_in, 2, axis=-1)
    return (jax.nn.silu(g) * u) @ w_out


def in_projection(h, w_in):
    b, l, _ = h.shape
    z = h @ w_in
    cuts = [D_ATTN, 2 * D_ATTN, 3 * D_ATTN, 3 * D_ATTN + D_LRU, 3 * D_ATTN + 2 * D_LRU]
    q, k, v, xl, gl, gates = jnp.split(z, cuts, axis=-1)
    q = q.reshape(b, l, N_HEADS, HEAD_DIM)
    k = k.reshape(b, l, N_HEADS, HEAD_DIM)
    v = v.reshape(b, l, N_HEADS, HEAD_DIM)
    return q, k, v, xl, gl, gates


def context_attention(q, k, v):
    s = jnp.einsum('bqhd,bkhd->bhqk', q, k).astype(jnp.float32) * (HEAD_DIM ** -0.5)
    p = jax.nn.softmax(s, axis=-1).astype(v.dtype)
    o = jnp.einsum('bhqk,bkhd->bqhd', p, v)
    return o.reshape(q.shape[0], q.shape[1], D_ATTN)


def neighbourhood_attention(q, k, v, kc, vc, rpb):
    b, l, nh, dh = q.shape
    rows = l // GRID_W
    kh = min(WIN_H, rows)
    scale = HEAD_DIM ** -0.5
    qg = q.reshape(b, rows, GRID_W, nh, dh)
    kg = k.reshape(b, rows, GRID_W, nh, dh)
    vg = v.reshape(b, rows, GRID_W, nh, dh)
    r = jnp.arange(rows)
    row_start = jnp.clip(r - kh // 2, 0, rows - kh)
    key_rows = row_start[:, None] + jnp.arange(kh)[None, :]
    kb = kg[:, key_rows].reshape(b, rows, kh * GRID_W, nh, dh)
    vb = vg[:, key_rows].reshape(b, rows, kh * GRID_W, nh, dh)
    cols = jnp.arange(GRID_W)
    col_start = jnp.clip(cols - WIN_W // 2, 0, GRID_W - WIN_W)
    in_win = (cols[None, :] >= col_start[:, None]) & (cols[None, :] < col_start[:, None] + WIN_W)
    mask = jnp.broadcast_to(in_win[:, None, :], (GRID_W, kh, GRID_W)).reshape(GRID_W, kh * GRID_W)
    dr = key_rows - r[:, None] + (WIN_H - 1)
    dc = jnp.clip(cols[None, :] - cols[:, None], -(WIN_W - 1), WIN_W - 1) + (WIN_W - 1)
    bias = rpb[:, dr[:, None, :, None], dc[None, :, None, :]]
    bias = bias.reshape(nh, rows, GRID_W, kh * GRID_W).astype(jnp.float32)
    s_win = jnp.einsum('brqhd,brkhd->bhrqk', qg, kb).astype(jnp.float32) * scale + bias
    s_win = jnp.where(mask, s_win, NEG_INF)
    s_ctx = jnp.einsum('brqhd,bhkd->bhrqk', qg, kc).astype(jnp.float32) * scale
    p = jax.nn.softmax(jnp.concatenate([s_win, s_ctx], axis=-1), axis=-1).astype(v.dtype)
    nw = kh * GRID_W
    o = (jnp.einsum('bhrqk,brkhd->brqhd', p[..., :nw], vb)
         + jnp.einsum('bhrqk,bhkd->brqhd', p[..., nw:], vc))
    return o.reshape(b, l, D_ATTN)


def dwconv_centred(x, w, bias):
    l = x.shape[1]
    left = CONV_W // 2
    xp = jnp.pad(x, ((0, 0), (left, CONV_W - 1 - left), (0, 0)))
    out = bias
    for j in range(CONV_W):
        out = out + xp[:, j:j + l] * w[j]
    return out


def blockdiag(x, w):
    b, l, _ = x.shape
    xb = x.reshape(b, l, LRU_BLOCKS, LRU_BLOCK)
    return jnp.einsum('blnc,ncd->blnd', xb, w.astype(jnp.float32)).reshape(b, l, D_LRU)


def linear_scan(a, bterm, h0):
    def comb(e1, e2):
        a1, b1 = e1
        a2, b2 = e2
        return a1 * a2, a2 * b1 + b2
    a_cum, b_cum = lax.associative_scan(comb, (a, bterm), axis=1)
    return b_cum + a_cum * h0[:, None, :]


def rglru_direction(xc, wa, ba, wi, bi, lam, h0, reverse):
    xs = xc[:, ::-1] if reverse else xc
    r = jax.nn.sigmoid(blockdiag(xs, wa) + ba.astype(jnp.float32))
    i = jax.nn.sigmoid(blockdiag(xs, wi) + bi.astype(jnp.float32))
    log_a = -LRU_C * r * jax.nn.softplus(-lam.astype(jnp.float32))
    a = jnp.exp(log_a)
    bterm = jnp.sqrt(-jnp.expm1(2.0 * log_a)) * (i * xs)
    h = linear_scan(a, bterm, h0.astype(jnp.float32))
    h_final = h[:, -1]
    if reverse:
        h = h[:, ::-1]
    return h, h_final


def rglru_branch(xl, gl, p, h0_f, h0_b):
    xc = dwconv_centred(xl, p['conv_w'], p['conv_b']).astype(jnp.float32)
    hf, hf_T = rglru_direction(xc, p['lru_wa'][0], p['lru_ba'][0], p['lru_wi'][0], p['lru_bi'][0],
                               p['lru_lambda'][0], h0_f, False)
    hb, hb_T = rglru_direction(xc, p['lru_wa'][1], p['lru_ba'][1], p['lru_wi'][1], p['lru_bi'][1],
                               p['lru_lambda'][1], h0_b, True)
    y = ((hf + hb) * jax.nn.gelu(gl.astype(jnp.float32))).astype(xl.dtype)
    h_final = jnp.stack([hf_T, hb_T], axis=1).astype(xl.dtype)
    return y, h_final


def merge_branches(attn, lru, gates, p):
    g_attn, g_lru = jnp.split(gates, 2, axis=-1)
    m = (jax.nn.sigmoid(g_attn) * (attn @ p['w_br_attn'])
         + jax.nn.sigmoid(g_lru) * (lru @ p['w_br_lru']))
    return m @ p['w_out']


def context_mixer(h, p):
    q, k, v, xl, gl, gates = in_projection(h, p['w_in'])
    attn = context_attention(q, k, v)
    zero = jnp.zeros((h.shape[0], D_LRU), jnp.float32)
    lru, h_final = rglru_branch(xl, gl, p, zero, zero)
    out = merge_branches(attn, lru, gates, p)
    return out, (k.transpose(0, 2, 1, 3), v.transpose(0, 2, 1, 3), h_final)


def latent_mixer(h, p, kc, vc, h0):
    q, k, v, xl, gl, gates = in_projection(h, p['w_in'])
    attn = neighbourhood_attention(q, k, v, kc, vc, p['rpb'])
    lru, _ = rglru_branch(xl, gl, p, h0[:, 0], h0[:, 1])
    return merge_branches(attn, lru, gates, p), None


def apply_layer(x, cond, p, mixer):
    mods = jax.nn.silu(cond) @ p['w_mod'] + p['b_mod']
    s1, sc1, g1, s2, sc2, g2, s3, sc3, g3 = jnp.split(mods, N_MOD, axis=-1)
    h = modulate(rmsnorm(x, p['norm_g'][0]), s1, sc1)
    x = x + 0.5 * g1[:, None, :] * swiglu(h, p['ffn1_w_in'], p['ffn1_w_out'])
    h = modulate(rmsnorm(x, p['norm_g'][1]), s2, sc2)
    out, extras = mixer(h, p)
    x = x + g2[:, None, :] * out
    h = modulate(rmsnorm(x, p['norm_g'][2]), s3, sc3)
    x = x + 0.5 * g3[:, None, :] * swiglu(h, p['ffn2_w_in'], p['ffn2_w_out'])
    return x, extras


def setup_inputs(seed: int = 0) -> dict:
    key = jax.random.key(seed)
    ks = jax.random.split(key, 32)
    f32 = jnp.float32
    nrm = lambda k, shape, s: jax.random.normal(k, shape, f32) * s
    a0 = jax.random.uniform(ks[20], (DEPTH, 2, D_LRU), f32, 0.9, 0.999)
    return {
        'x_prompt': nrm(ks[0], (BATCH, SEQ, D_MODEL), 1.0),
        'x_sample': nrm(ks[1], (DEC_BATCH, DEC_SEQ, D_MODEL), 1.0),
        'cache_k': nrm(ks[2], (DEC_BATCH, DEPTH, N_HEADS, PAST_LEN, HEAD_DIM), 1.0),
        'cache_v': nrm(ks[3], (DEC_BATCH, DEPTH, N_HEADS, PAST_LEN, HEAD_DIM), 1.0),
        'state_lru': nrm(ks[4], (DEC_BATCH, DEPTH, 2, D_LRU), 0.5),
        'c': nrm(ks[5], (DEC_BATCH, D_MODEL), 1.0),
        'c_ctx': nrm(ks[6], (D_MODEL,), 1.0),
        'w_mod': nrm(ks[7], (DEPTH, D_MODEL, N_MOD * D_MODEL), 0.5 * D_MODEL ** -0.5),
        'b_mod': nrm(ks[8], (DEPTH, N_MOD * D_MODEL), 0.02),
        'norm_g': 1.0 + nrm(ks[9], (DEPTH, 3, D_MODEL), 0.02),
        'ffn1_w_in': nrm(ks[10], (DEPTH, D_MODEL, 2 * D_FF), D_MODEL ** -0.5),
        'ffn1_w_out': nrm(ks[11], (DEPTH, D_FF, D_MODEL), D_FF ** -0.5),
        'w_in': nrm(ks[12], (DEPTH, D_MODEL, IN_WIDTH), D_MODEL ** -0.5),
        'rpb': nrm(ks[13], (DEPTH, N_HEADS, 2 * WIN_H - 1, 2 * WIN_W - 1), 0.1),
        'conv_w': nrm(ks[14], (DEPTH, CONV_W, D_LRU), CONV_W ** -0.5),
        'conv_b': nrm(ks[15], (DEPTH, D_LRU), 0.02),
        'lru_wa': nrm(ks[16], (DEPTH, 2, LRU_BLOCKS, LRU_BLOCK, LRU_BLOCK), LRU_BLOCK ** -0.5),
        'lru_ba': nrm(ks[17], (DEPTH, 2, D_LRU), 0.02),
        'lru_wi': nrm(ks[18], (DEPTH, 2, LRU_BLOCKS, LRU_BLOCK, LRU_BLOCK), LRU_BLOCK ** -0.5),
        'lru_bi': nrm(ks[19], (DEPTH, 2, D_LRU), 0.02),
        'lru_lambda': jnp.log(a0) - jnp.log1p(-a0),
        'w_br_attn': nrm(ks[21], (DEPTH, D_ATTN, D_MODEL), D_ATTN ** -0.5),
        'w_br_lru': nrm(ks[22], (DEPTH, D_LRU, D_MODEL), D_LRU ** -0.5),
        'w_out': nrm(ks[23], (DEPTH, D_MODEL, D_MODEL), D_MODEL ** -0.5),
        'ffn2_w_in': nrm(ks[24], (DEPTH, D_MODEL, 2 * D_FF), D_MODEL ** -0.5),
        'ffn2_w_out': nrm(ks[25], (DEPTH, D_FF, D_MODEL), D_FF ** -0.5),
        'final_g': 1.0 + nrm(ks[26], (D_MODEL,), 0.02),
    }


def reference(x_prompt, x_sample, cache_k, cache_v, state_lru, c, c_ctx, w_mod, b_mod, norm_g,
              ffn1_w_in, ffn1_w_out, w_in, rpb, conv_w, conv_b, lru_wa, lru_ba, lru_wi, lru_bi,
              lru_lambda, w_br_attn, w_br_lru, w_out, ffn2_w_in, ffn2_w_out, final_g):
    yp = x_prompt
    ys = x_sample
    ks_, vs_, hs_ = [], [], []
    for l in range(DEPTH):
        p = {
            'w_mod': w_mod[l], 'b_mod': b_mod[l], 'norm_g': norm_g[l],
            'ffn1_w_in': ffn1_w_in[l], 'ffn1_w_out': ffn1_w_out[l], 'w_in': w_in[l], 'rpb': rpb[l],
            'conv_w': conv_w[l], 'conv_b': conv_b[l], 'lru_wa': lru_wa[l], 'lru_ba': lru_ba[l],
            'lru_wi': lru_wi[l], 'lru_bi': lru_bi[l], 'lru_lambda': lru_lambda[l],
            'w_br_attn': w_br_attn[l], 'w_br_lru': w_br_lru[l], 'w_out': w_out[l],
            'ffn2_w_in': ffn2_w_in[l], 'ffn2_w_out': ffn2_w_out[l],
        }
        yp, (k_l, v_l, h_l) = apply_layer(yp, c_ctx[None, :], p, context_mixer)
        ks_.append(k_l)
        vs_.append(v_l)
        hs_.append(h_l)
        mixer = functools.partial(latent_mixer, kc=cache_k[:, l], vc=cache_v[:, l], h0=state_lru[:, l])
        ys, _ = apply_layer(ys, c, p, mixer)
    y_prompt = rmsnorm(yp, final_g)
    y_sample = rmsnorm(ys, final_g)
    new_cache_k = jnp.stack(ks_, axis=1)
    new_cache_v = jnp.stack(vs_, axis=1)
    new_state_lru = jnp.stack(hs_, axis=1)
    return (y_prompt, y_sample, new_cache_k, new_cache_v, new_state_lru)
```

```cpp
#include <hip/hip_runtime.h>
#include <cstdio>
#include <cstdint>

#ifndef MK_N_LAUNCHES
#define MK_N_LAUNCHES 1
#endif

namespace pg8 {
#define PG8_LAS __attribute__((address_space(3)))
typedef unsigned short bf16_t;
typedef short bf16x8 __attribute__((ext_vector_type(8)));
typedef float f32x4 __attribute__((ext_vector_type(4)));
typedef unsigned u32x4 __attribute__((ext_vector_type(4)));
constexpr int BM = 256, BK = 64, HALF = 128, HTB = HALF * BK * 2, STAGE_BYTES = 8 * HTB, NXCD = 8, WGM = 8;

__host__ __device__ __forceinline__ int lds_byte(int r, int c) { const int st = (r >> 4) * 2 + (c >> 5), rr = r & 15, cc = c & 31, ob = rr * 64 + cc * 2; return st * 1024 + (ob ^ (((ob >> 9) & 1) << 5)); }
__host__ __device__ __forceinline__ void stage_rc(int b, int& R, int& C) { const int st = b / 1024, sb = b % 1024, swz = sb ^ (((sb >> 9) & 1) << 5); R = (st >> 1) * 16 + swz / 64; C = (st & 1) * 32 + (swz % 64) / 2; }
__host__ __device__ __forceinline__ int perm32(int rho) { const int n = rho >> 4, i = rho & 15; return 8 * (i >> 2) + 4 * n + (i & 3); }

struct Unit { int pm, pn; };
struct Gemm { const bf16_t* A; const bf16_t* Bt; int M, N, K; };

struct StaticOrder {
    int nM, nN, nwg, G, c;
    __host__ __device__ void init(int M, int N, int G_, int c_) { nM = M / BM; nN = N / BM; nwg = nM * nN; G = G_; c = c_; }
    __host__ __device__ bool next(int i, Unit& u) const {
        const long L = (long)i * G + c; if (L >= nwg) return false;
        int wgid = (int)L; { const int q = nwg / NXCD, r = nwg % NXCD, xcd = wgid % NXCD, off = wgid / NXCD; wgid = (xcd < r ? xcd * (q + 1) : r * (q + 1) + (xcd - r) * q) + off; }
        const int nig = WGM * nN, gid = wgid / nig, fm = gid * WGM, gsz = (nM - fm) < WGM ? (nM - fm) : WGM;
        u.pm = fm + ((wgid % nig) % gsz); u.pn = (wgid % nig) / gsz; return true;
    }
    __device__ __forceinline__ void a_ready(const Unit&) const {}
    __device__ __forceinline__ void done(const Unit&) const {}
};

template <class Epi, class Sched, bool ALIGN_EPI = false, bool SP2 = false>
__device__ __forceinline__ void gemm_phase(PG8_LAS unsigned char* lds, const Gemm g, const Sched& S, const Epi& E) {
    const int tid = threadIdx.x, wid = __builtin_amdgcn_readfirstlane(tid >> 6), lane = tid & 63, wr = wid >> 2, wc = wid & 3, fr = lane & 15, fq = lane >> 4;
    const int K = g.K, nt = K / BK;
    unsigned voffA[2], voffB[2];
#pragma unroll
    for (int i = 0; i < 2; ++i) { int R, C; stage_rc(tid * 16 + i * 8192, R, C); const int Rb = Epi::PERM ? ((R & ~31) + perm32(R & 31)) : R;
        voffA[i] = (unsigned)(R * K + C) * 2u; voffB[i] = (unsigned)(Rb * K + C) * 2u; }
    const size_t kstep = (size_t)(BK * 2);
    const size_t hstep = (size_t)HALF * K * 2;
    const size_t tstep = 2 * hstep;
    const unsigned ldsw = (unsigned)wid * 1024u;
    const int aoff = lds_byte(wr * 64 + fr, fq * 8), boff = lds_byte(wc * 32 + fr, fq * 8);
#define PG8_SA(b, h) (((b) * 2 + (h)) * HTB)
#define PG8_SB(b, h) ((4 + (b) * 2 + (h)) * HTB)
#define PG8_STAGE(bufoff, gbase, voff) do { _Pragma("unroll") for (int _i = 0; _i < 2; ++_i) \
        __builtin_amdgcn_global_load_lds((const unsigned*)((const char*)(gbase) + (voff)[_i]), (PG8_LAS unsigned*)(lds + (bufoff) + ldsw + _i * 8192), 16, 0, 0); } while (0)
#define PG8_LDA(dst, b, h) do { _Pragma("unroll") for (int m = 0; m < 4; ++m) _Pragma("unroll") for (int k = 0; k < 2; ++k) dst[m][k] = *(const PG8_LAS bf16x8*)(lds + PG8_SA(b, h) + aoff + m * 2048 + k * 1024); } while (0)
#define PG8_LDB(dst, b, h) do { _Pragma("unroll") for (int n = 0; n < 2; ++n) _Pragma("unroll") for (int k = 0; k < 2; ++k) dst[n][k] = *(const PG8_LAS bf16x8*)(lds + PG8_SB(b, h) + boff + n * 2048 + k * 1024); } while (0)
#define PG8_MMA(ai, bj, At, Bt) do { __builtin_amdgcn_s_setprio(1); _Pragma("unroll") for (int m = 0; m < 4; ++m) _Pragma("unroll") for (int n = 0; n < 2; ++n) _Pragma("unroll") for (int k = 0; k < 2; ++k) \
        acc[ai][bj][m][n] = __builtin_amdgcn_mfma_f32_16x16x32_bf16(Bt[n][k], At[m][k], acc[ai][bj][m][n], 0, 0, 0); __builtin_amdgcn_s_setprio(0); } while (0)
#define PG8_WAIT_V(n) asm volatile("s_waitcnt vmcnt(" #n ")" ::: "memory")
#define PG8_WAIT_L(n) asm volatile("s_waitcnt lgkmcnt(" #n ")" ::: "memory")
#define PG8_BAR __builtin_amdgcn_s_barrier()
#define PG8_SCHED __builtin_amdgcn_sched_barrier(0)
    Unit cur, nxt; int ui = 0;
    if (!S.next(0, cur)) return;
    f32x4 acc[2][2][4][2];
#pragma unroll
    for (int a = 0; a < 2; ++a)
#pragma unroll
        for (int b = 0; b < 2; ++b)
#pragma unroll
            for (int m = 0; m < 4; ++m)
#pragma unroll
                for (int n = 0; n < 2; ++n) acc[a][b][m][n] = (f32x4){0.f, 0.f, 0.f, 0.f};
    bf16x8 At[4][2], B0[2][2], B1[2][2];
    const char* cA = (const char*)g.A + (size_t)cur.pm * tstep; const char* cB = (const char*)g.Bt + (size_t)cur.pn * tstep;
    S.a_ready(cur);
    if constexpr (SP2) {
        PG8_STAGE(PG8_SB(0, 0), cB, voffB); PG8_STAGE(PG8_SB(0, 1), cB + hstep, voffB); PG8_STAGE(PG8_SA(0, 0), cA, voffA); PG8_STAGE(PG8_SA(0, 1), cA + hstep, voffA);
        if (wr == 1) PG8_BAR;
        PG8_WAIT_V(2); PG8_BAR;
        PG8_STAGE(PG8_SB(1, 0), cB + kstep, voffB); PG8_STAGE(PG8_SA(1, 0), cA + kstep, voffA); PG8_STAGE(PG8_SB(1, 1), cB + hstep + kstep, voffB);
        PG8_WAIT_V(6); PG8_BAR;
    } else {
        PG8_STAGE(PG8_SB(0, 0), cB, voffB); PG8_STAGE(PG8_SA(0, 0), cA, voffA); PG8_STAGE(PG8_SB(0, 1), cB + hstep, voffB); PG8_STAGE(PG8_SA(0, 1), cA + hstep, voffA);
        if (wr == 1) PG8_BAR;
        PG8_WAIT_V(4); PG8_BAR;
        PG8_STAGE(PG8_SB(1, 0), cB + kstep, voffB); PG8_STAGE(PG8_SA(1, 0), cA + kstep, voffA); PG8_STAGE(PG8_SB(1, 1), cB + hstep + kstep, voffB);
        PG8_WAIT_V(6); PG8_BAR;
    }
    for (;;) {
        const bool has_next = S.next(ui + 1, nxt);
        const char* nA = has_next ? (const char*)g.A + (size_t)nxt.pm * tstep : cA; const char* nB = has_next ? (const char*)g.Bt + (size_t)nxt.pn * tstep : cB;
        for (int t = 0; t < nt; t += 2) {
            const bool last = (t == nt - 2);
            const char* a1 = cA + (size_t)(t + 1) * kstep;
            const char* a2 = last ? nA : cA + (size_t)(t + 2) * kstep; const char* b2 = last ? nB : cB + (size_t)(t + 2) * kstep;
            const char* a3 = a2 + kstep; const char* b3 = b2 + kstep;
            if (last && has_next) S.a_ready(nxt);
            if constexpr (SP2) {
            PG8_LDB(B0, 0, 0); PG8_LDB(B1, 0, 1); PG8_SCHED; PG8_LDA(At, 0, 0); PG8_STAGE(PG8_SA(1, 1), a1 + hstep, voffA);
            PG8_WAIT_V(8); PG8_WAIT_L(0); PG8_BAR; PG8_MMA(0, 0, At, B0); PG8_MMA(0, 1, At, B1); PG8_BAR; PG8_SCHED;
            PG8_LDA(At, 0, 1); PG8_STAGE(PG8_SB(0, 0), b2, voffB); PG8_STAGE(PG8_SB(0, 1), b2 + hstep, voffB); PG8_STAGE(PG8_SA(0, 0), a2, voffA);
            PG8_WAIT_V(8); PG8_WAIT_L(0); PG8_BAR; PG8_MMA(1, 0, At, B0); PG8_MMA(1, 1, At, B1); PG8_BAR; PG8_SCHED;
            PG8_LDB(B0, 1, 0); PG8_LDB(B1, 1, 1); PG8_SCHED; PG8_LDA(At, 1, 0); PG8_STAGE(PG8_SA(0, 1), a2 + hstep, voffA);
            PG8_WAIT_V(8); PG8_WAIT_L(0); PG8_BAR; PG8_MMA(0, 0, At, B0); PG8_MMA(0, 1, At, B1); PG8_BAR; PG8_SCHED;
            PG8_LDA(At, 1, 1); PG8_STAGE(PG8_SB(1, 0), b3, voffB); PG8_STAGE(PG8_SB(1, 1), b3 + hstep, voffB); PG8_STAGE(PG8_SA(1, 0), a3, voffA);
            PG8_WAIT_V(8); PG8_WAIT_L(0); PG8_BAR; PG8_MMA(1, 0, At, B0); PG8_MMA(1, 1, At, B1); PG8_BAR; PG8_SCHED;
            } else {
            PG8_LDB(B0, 0, 0); PG8_SCHED; PG8_LDA(At, 0, 0); PG8_STAGE(PG8_SA(1, 1), a1 + hstep, voffA);
            PG8_WAIT_L(8); PG8_BAR; PG8_WAIT_L(0); PG8_MMA(0, 0, At, B0); PG8_BAR; PG8_SCHED;
            PG8_LDB(B1, 0, 1); PG8_STAGE(PG8_SB(0, 0), b2, voffB);
            PG8_BAR; PG8_WAIT_L(0); PG8_MMA(0, 1, At, B1); PG8_BAR;
            PG8_LDA(At, 0, 1); PG8_STAGE(PG8_SA(0, 0), a2, voffA);
            PG8_BAR; PG8_WAIT_L(0); PG8_MMA(1, 0, At, B0); PG8_BAR; PG8_SCHED;
            PG8_STAGE(PG8_SB(0, 1), b2 + hstep, voffB);
            PG8_WAIT_V(6); PG8_BAR; PG8_MMA(1, 1, At, B1); PG8_BAR;
            PG8_LDB(B0, 1, 0); PG8_SCHED; PG8_LDA(At, 1, 0); PG8_STAGE(PG8_SA(0, 1), a2 + hstep, voffA);
            PG8_WAIT_L(8); PG8_BAR; PG8_WAIT_L(0); PG8_MMA(0, 0, At, B0); PG8_BAR; PG8_SCHED;
            PG8_LDB(B1, 1, 1); PG8_STAGE(PG8_SB(1, 0), b3, voffB);
            PG8_BAR; PG8_WAIT_L(0); PG8_MMA(0, 1, At, B1); PG8_BAR;
            PG8_LDA(At, 1, 1); PG8_STAGE(PG8_SA(1, 0), a3, voffA);
            PG8_BAR; PG8_WAIT_L(0); PG8_MMA(1, 0, At, B0); PG8_BAR; PG8_SCHED;
            PG8_STAGE(PG8_SB(1, 1), b3 + hstep, voffB);
            PG8_WAIT_V(6); PG8_BAR; PG8_MMA(1, 1, At, B1); PG8_BAR;
            }
        }
        if constexpr (ALIGN_EPI) { if (wr == 0) PG8_BAR; }
        E(acc, cur, wr, wc, fr, fq); S.done(cur);
        if (!has_next) break;
#pragma unroll
        for (int a = 0; a < 2; ++a)
#pragma unroll
            for (int b = 0; b < 2; ++b)
#pragma unroll
                for (int m = 0; m < 4; ++m)
#pragma unroll
                    for (int n = 0; n < 2; ++n) acc[a][b][m][n] = (f32x4){0.f, 0.f, 0.f, 0.f};
        cur = nxt; cA = nA; cB = nB; ++ui;
        if constexpr (ALIGN_EPI) { if (wr == 1) PG8_BAR; }
    }
    PG8_WAIT_V(0);
    if constexpr (!ALIGN_EPI) { if (wr == 0) PG8_BAR; }
    PG8_BAR;
#undef PG8_SA
#undef PG8_SB
#undef PG8_STAGE
#undef PG8_LDA
#undef PG8_LDB
#undef PG8_MMA
#undef PG8_WAIT_V
#undef PG8_WAIT_L
#undef PG8_BAR
#undef PG8_SCHED
}
}

constexpr int NWAVES = 8;
constexpr int DM = 1024, NCTXB = 16, TCTX = 256, NLATB = 8, TLAT = 1024;
constexpr int MCTX = NCTXB * TCTX  , MLAT = NLATB * TLAT  , MROWS = MCTX + MLAT  ;
constexpr int DFF = 2816, NFF = 2 * DFF  , INW = 5632, DATT = 512, DLRU = 1024, NMODC = 9 * DM  ;
constexpr float EPS = 1e-6f;
constexpr float LOG2E = 1.4426950408889634f;
constexpr float QSCALE = 0.125f * LOG2E;
constexpr int NPH = 14;

constexpr size_t MiB = 1u << 20, HMiB = 1u << 19;
constexpr size_t WS_CTL = 0, CTL_ZERO_BYTES = 1 * MiB;
constexpr size_t WS_MODS = HMiB;
constexpr size_t WS_BT = 2 * MiB;
constexpr size_t WS_W1IN = 4 * MiB, WS_W1OUT = 15 * MiB, WS_WIN = 20 * MiB + HMiB, WS_WBA = 31 * MiB + HMiB, WS_WBL = 32 * MiB + HMiB,
                 WS_WOUT = 34 * MiB + HMiB, WS_W2IN = 36 * MiB + HMiB, WS_W2OUT = 47 * MiB + HMiB, WS_WL = 53 * MiB, WS_CK = 54 * MiB, WS_CVT = 56 * MiB;
constexpr size_t WS_H = 58 * MiB;
constexpr size_t WS_ACT = 82 * MiB;
constexpr size_t WS_Q = 82 * MiB, WS_K = 94 * MiB, WS_VT = 106 * MiB, WS_XL = 118 * MiB, WS_GG = 142 * MiB, WS_SGA = 166 * MiB, WS_SGB = 190 * MiB;
constexpr size_t WS_AO = 214 * MiB, WS_LO = 226 * MiB, WS_END = 250 * MiB;
static_assert(WS_SGA - WS_GG == WS_GG - WS_XL && WS_SGB - WS_SGA == WS_GG - WS_XL, "xl/gg/sga/sgb equally spaced");
constexpr size_t VT_LAT_OFF = (size_t)NCTXB * 8 * 64 * TCTX;
constexpr int CW_TMO = 0, CW_BAR = 4096;

constexpr size_t OUT_Y = 0, OUT_CK = (size_t)MROWS * DM, OUT_CV = OUT_CK + (size_t)NCTXB * 8 * TCTX * 64, OUT_ST = OUT_CV + (size_t)NCTXB * 8 * TCTX * 64;

constexpr int RING_OFF = 0, RING_BYTES = 131072;
constexpr int LDSCTL_OFF = RING_BYTES, MISC_OFF = LDSCTL_OFF + 320;
constexpr int LDS_BYTES = 147456;

#define GAS __attribute__((address_space(1)))
#define LAS __attribute__((address_space(3)))
typedef unsigned short bf16;
typedef unsigned v4u __attribute__((ext_vector_type(4)));
typedef unsigned v2u __attribute__((ext_vector_type(2)));
typedef float f32x4 __attribute__((ext_vector_type(4)));
typedef float f32x16 __attribute__((ext_vector_type(16)));
typedef short bf16x8 __attribute__((ext_vector_type(8)));
typedef short s16x4 __attribute__((ext_vector_type(4)));
typedef GAS unsigned gu32;
#define RLX_AGENT __ATOMIC_RELAXED, __HIP_MEMORY_SCOPE_AGENT
#define LDS_WAIT() asm volatile("s_waitcnt lgkmcnt(0)" ::: "memory")
#define VM_WAIT() asm volatile("s_waitcnt vmcnt(0)" ::: "memory")
typedef float f32x2_t __attribute__((ext_vector_type(2))); typedef __bf16 bf16x2_t __attribute__((ext_vector_type(2)));
__device__ __forceinline__ unsigned pk2(float lo, float hi) { f32x2_t v = {lo, hi}; bf16x2_t b = __builtin_convertvector(v, bf16x2_t); return __builtin_bit_cast(unsigned, b); }
__device__ __forceinline__ bf16 f2bf(float f) { return (bf16)(pk2(f, 0.f) & 0xffffu); }
__device__ __forceinline__ float bf2f(bf16 b) { return __builtin_bit_cast(float, (unsigned)b << 16); }
__device__ __forceinline__ float bflo(unsigned u) { return __builtin_bit_cast(float, u << 16); }
__device__ __forceinline__ float bfhi(unsigned u) { return __builtin_bit_cast(float, u & 0xffff0000u); }
__device__ __forceinline__ float fast_sigmoid(float x) { return __builtin_amdgcn_rcpf(1.f + __builtin_amdgcn_exp2f(-LOG2E * x)); }
__device__ __forceinline__ float silu_f(float x) { return x * fast_sigmoid(x); }
__device__ __forceinline__ float gelu_tanh_f(float x) { const float u = 0.7978845608028654f * (x + 0.044715f * x * x * x); return x * fast_sigmoid(2.f * u); }
__device__ __forceinline__ int crow(int r, int hi) { return (r & 3) + 8 * (r >> 2) + 4 * hi; }
__device__ __forceinline__ float wave_sum(float v) {
#pragma unroll
    for (int o = 1; o < 64; o <<= 1) v += __shfl_xor(v, o);
    return v;
}

#define XB_TMO      128
#define XB_XCNT(j)  (256  + 64 * (j))
#define XB_XSUB(j)  (1280 + 64 * (j))
#define XB_XGEN(j)  (2304 + 64 * (j))
#define XB_TOP      3328
#define XB_TOPGEN   3392
#define XCD_BAR_WORDS 3456
#define XB_SPIN_CAP (1u << 18)
__device__ __forceinline__ unsigned xb_ld(unsigned* p)              { return __hip_atomic_load(p, __ATOMIC_RELAXED, __HIP_MEMORY_SCOPE_AGENT); }
__device__ __forceinline__ unsigned xb_add(unsigned* p, unsigned v) { return __hip_atomic_fetch_add(p, v, __ATOMIC_RELAXED, __HIP_MEMORY_SCOPE_AGENT); }
__device__ __forceinline__ unsigned xb_xcc_id() { return (unsigned)__builtin_amdgcn_s_getreg((3 << 11) | 20) & 0xFu; }
#define XB_SPIN(cond, bar) do { unsigned _sp = 0; while (cond) { __builtin_amdgcn_s_sleep(1); \
    if ((++_sp & 255u) == 0u) { if (xb_ld(&(bar)[XB_TMO])) break; if (_sp > XB_SPIN_CAP) { atomicAdd(&(bar)[XB_TMO], 1u); break; } } } } while (0)
struct XcdBarrier { unsigned* bar; unsigned x; volatile LAS unsigned* st; };
__device__ __forceinline__ XcdBarrier xcd_barrier_post(unsigned* bar, volatile LAS unsigned* st) {
    XcdBarrier b; b.bar = bar; b.x = xb_xcc_id(); b.st = st;
    if (threadIdx.x == 0) (void)xb_add(&bar[XB_XCNT(b.x)], 1u);
    return b;
}
__device__ __forceinline__ void xcd_barrier_complete(unsigned* bar, unsigned x, unsigned& nloc, unsigned& nx) {
    const unsigned G = gridDim.x * gridDim.y * gridDim.z;
    unsigned sum, cnt, mine, sp = 0u;
    for (;;) {
        sum = 0u; cnt = 0u; mine = 0u;
#pragma unroll
        for (unsigned j = 0; j < 16; ++j) { const unsigned c = xb_ld(&bar[XB_XCNT(j)]); sum += c; cnt += (c > 0u) ? 1u : 0u; mine = (j == x) ? c : mine; }
        if (sum == G) break;
        __builtin_amdgcn_s_sleep(1);
        if ((++sp & 255u) == 0u) { if (xb_ld(&bar[XB_TMO])) break; if (sp > XB_SPIN_CAP) { atomicAdd(&bar[XB_TMO], 1u); break; } }
    }
    nloc = mine > 0u ? mine : 1u; nx = cnt > 0u ? cnt : 1u;
}
__device__ __forceinline__ void xcd_barrier(const XcdBarrier& b) {
    asm volatile("s_waitcnt vmcnt(0)" ::: "memory");
    __syncthreads();
    if (threadIdx.x == 0) {
        unsigned* bar = b.bar;
        __builtin_amdgcn_s_waitcnt(0);
        unsigned nloc = b.st[0], nx = b.st[1];
        if (nloc == 0u) { xcd_barrier_complete(bar, b.x, nloc, nx); b.st[0] = nloc; b.st[1] = nx; }
        const unsigned old = xb_add(&bar[XB_XSUB(b.x)], 1u);
        const unsigned gen = old / nloc;
        if (old + 1u == (gen + 1u) * nloc) {
            __builtin_amdgcn_fence(__ATOMIC_RELEASE, "agent");
            asm volatile("s_waitcnt vmcnt(0)" ::: "memory");
            const unsigned og = xb_add(&bar[XB_TOP], 1u);
            const unsigned tg = og / nx;
            if (og + 1u == (tg + 1u) * nx) xb_add(&bar[XB_TOPGEN], 1u);
            else XB_SPIN(xb_ld(&bar[XB_TOPGEN]) == tg, bar);
            __builtin_amdgcn_fence(__ATOMIC_ACQUIRE, "agent");
            xb_add(&bar[XB_XGEN(b.x)], 1u);
            asm volatile("s_waitcnt vmcnt(0)" ::: "memory");
        } else {
            XB_SPIN(xb_ld(&bar[XB_XGEN(b.x)]) == gen, bar);
            __builtin_amdgcn_fence(__ATOMIC_ACQUIRE, "agent");
            asm volatile("s_waitcnt vmcnt(0)" ::: "memory");
        }
    }
    __syncthreads();
}

struct Args { const float* in[27]; float* out; unsigned char* ws; int ph_lo, ph_hi, li, pad; };
struct Frame {
    LAS unsigned char* lds;
    int tid, lane, wave, G;
    unsigned char* ws; float* out;
};
enum { I_XP = 0, I_XS, I_CACHE_K, I_CACHE_V, I_STATE, I_C, I_CCTX, I_WMOD, I_BMOD, I_NORMG, I_F1IN, I_F1OUT, I_WIN, I_RPB, I_CONVW, I_CONVB, I_LRUWA, I_LRUBA, I_LRUWI, I_LRUBI, I_LRULAM,
       I_WBRA, I_WBRL, I_WOUT, I_F2IN, I_F2OUT, I_FINALG };
#define WSB(F, off) ((bf16*)((F).ws + (off)))
#define WSF(F, off) ((float*)((F).ws + (off)))

using pg8::Unit;
__device__ __forceinline__ int unit_modrow(int pm) { return pm < 16 ? 8 : ((pm - 16) >> 2); }

struct EpiSwiglu {
    static constexpr bool PERM = true, AFTER_DRAIN = false;
    bf16* O;
    __device__ __forceinline__ void operator()(const f32x4 (&acc)[2][2][4][2], const Unit& u, int wr, int wc, int fr, int fq) const {
        const int row0 = u.pm * 256 + wr * 64 + fr, col0 = u.pn * 128 + wc * 32 + 8 * fq;
#pragma unroll
        for (int ai = 0; ai < 2; ++ai)
#pragma unroll
            for (int m = 0; m < 4; ++m) {
                const f32x4 g0 = acc[ai][0][m][0], g1 = acc[ai][0][m][1], u0 = acc[ai][1][m][0], u1 = acc[ai][1][m][1];
                v4u w;
                w.x = pk2(silu_f(g0[0]) * u0[0], silu_f(g0[1]) * u0[1]); w.y = pk2(silu_f(g0[2]) * u0[2], silu_f(g0[3]) * u0[3]);
                w.z = pk2(silu_f(g1[0]) * u1[0], silu_f(g1[1]) * u1[1]); w.w = pk2(silu_f(g1[2]) * u1[2], silu_f(g1[3]) * u1[3]);
                *(v4u*)(O + (size_t)(row0 + ai * 128 + m * 16) * DFF + col0) = w;
            }
    }
};
struct EpiResid {
    static constexpr bool PERM = false, AFTER_DRAIN = false;
    const float* base_ctx; const float* base_lat; float* out; const float* gate; float coef;
    __device__ __forceinline__ void operator()(const f32x4 (&acc)[2][2][4][2], const Unit& u, int wr, int wc, int fr, int fq) const {
        const int rl0 = wr * 64 + fr, col0 = u.pn * 256 + wc * 32 + 4 * fq;
        const float* bp = (u.pm < 16 ? base_ctx + (size_t)u.pm * 256 * DM : base_lat + (size_t)(u.pm - 16) * 256 * DM) + col0;
        float* op = out + (size_t)u.pm * 256 * DM + col0;
        const float* gp = gate + (size_t)unit_modrow(u.pm) * NMODC + col0;
        f32x4 gv[2][2];
#pragma unroll
        for (int bj = 0; bj < 2; ++bj)
#pragma unroll
            for (int n = 0; n < 2; ++n) gv[bj][n] = *(const f32x4*)(gp + bj * 128 + n * 16) * coef;
#pragma unroll
        for (int ai = 0; ai < 2; ++ai)
#pragma unroll
            for (int m = 0; m < 4; ++m) { const size_t ro = (size_t)(rl0 + ai * 128 + m * 16) * DM;
#pragma unroll
                for (int bj = 0; bj < 2; ++bj)
#pragma unroll
                    for (int n = 0; n < 2; ++n) { const f32x4 b = *(const f32x4*)(bp + ro + bj * 128 + n * 16); *(f32x4*)(op + ro + bj * 128 + n * 16) = b + gv[bj][n] * acc[ai][bj][m][n]; } }
    }
};
struct EpiInProj {
    static constexpr bool PERM = true, AFTER_DRAIN = false;
    bf16 *q  , *vT, *xl  ; float *ock  ;
    __device__ __forceinline__ void operator()(const f32x4 (&acc)[2][2][4][2], const Unit& u, int wr, int wc, int fr, int fq) const {
        const int pn = u.pn, pm = u.pm;
        const int rl0 = wr * 64 + fr, lc0 = wc * 32 + 8 * fq;
        if (pn < 4) {
            const bool isq = pn < 2; const float sc = isq ? QSCALE : 1.f;
            bf16* dst = q + (isq ? (size_t)0 : (size_t)(WS_K - WS_Q) / 2) + (size_t)pm * 256 * DATT + (pn & 1) * 256 + lc0;
#pragma unroll
            for (int ai = 0; ai < 2; ++ai)
#pragma unroll
                for (int m = 0; m < 4; ++m) { const int rl = rl0 + ai * 128 + m * 16;
#pragma unroll
                    for (int bj = 0; bj < 2; ++bj) { const f32x4 v0 = acc[ai][bj][m][0] * sc, v1 = acc[ai][bj][m][1] * sc;
                        v4u w; w.x = pk2(v0[0], v0[1]); w.y = pk2(v0[2], v0[3]); w.z = pk2(v1[0], v1[1]); w.w = pk2(v1[2], v1[3]);
                        *(v4u*)(dst + (size_t)rl * DATT + bj * 128) = w;
                        if (!isq && pm < 16) { const int c = (pn & 1) * 256 + bj * 128 + lc0, hh = c >> 6, d = c & 63;
                            float* o = ock + (((size_t)pm * 8 + hh) * 256 + rl) * 64 + d; *(f32x4*)o = v0; *(f32x4*)(o + 4) = v1; } } }
        } else if (pn < 6) {
            int T, t0; bf16* vb;
            if (pm < 16) { T = TCTX; t0 = 0; vb = vT + (size_t)pm * 8 * 64 * TCTX; }
            else { const int lr = (pm - 16) * 256; T = TLAT; t0 = lr & 1023; vb = vT + VT_LAT_OFF + (size_t)(lr >> 10) * 8 * 64 * TLAT; }
#pragma unroll
            for (int ai = 0; ai < 2; ++ai)
#pragma unroll
                for (int m = 0; m < 4; ++m) { const int rl = rl0 + ai * 128 + m * 16;
#pragma unroll
                    for (int bj = 0; bj < 2; ++bj) { const f32x4 v0 = acc[ai][bj][m][0], v1 = acc[ai][bj][m][1];
                        const int c = (pn & 1) * 256 + bj * 128 + lc0;
                        bf16* p = vb + (size_t)c * T + t0 + rl;
                        p[0] = f2bf(v0[0]); p[(size_t)T] = f2bf(v0[1]); p[(size_t)2 * T] = f2bf(v0[2]); p[(size_t)3 * T] = f2bf(v0[3]);
                        p[(size_t)4 * T] = f2bf(v1[0]); p[(size_t)5 * T] = f2bf(v1[1]); p[(size_t)6 * T] = f2bf(v1[2]); p[(size_t)7 * T] = f2bf(v1[3]);
                        if (pm < 16) { const int hh = c >> 6, d = c & 63;
                            float* o = ock + (OUT_CV - OUT_CK) + (((size_t)pm * 8 + hh) * 256 + rl) * 64 + d; *(f32x4*)o = v0; *(f32x4*)(o + 4) = v1; } } }
        } else {
            const int grp = (pn - 6) >> 2;
            bf16* dst = xl + (size_t)grp * ((WS_GG - WS_XL) / 2) + (size_t)pm * 256 * DM + ((pn - 6) & 3) * 256 + lc0;
#pragma unroll
            for (int ai = 0; ai < 2; ++ai)
#pragma unroll
                for (int m = 0; m < 4; ++m) { const int rl = rl0 + ai * 128 + m * 16;
#pragma unroll
                    for (int bj = 0; bj < 2; ++bj) { f32x4 v0 = acc[ai][bj][m][0], v1 = acc[ai][bj][m][1];
                        if (grp == 1) {
#pragma unroll
                            for (int e = 0; e < 4; ++e) { v0[e] = gelu_tanh_f(v0[e]); v1[e] = gelu_tanh_f(v1[e]); }
                        } else if (grp >= 2) {
#pragma unroll
                            for (int e = 0; e < 4; ++e) { v0[e] = fast_sigmoid(v0[e]); v1[e] = fast_sigmoid(v1[e]); }
                        }
                        v4u w; w.x = pk2(v0[0], v0[1]); w.y = pk2(v0[2], v0[3]); w.z = pk2(v1[0], v1[1]); w.w = pk2(v1[2], v1[3]);
                        *(v4u*)(dst + (size_t)rl * DM + bj * 128) = w; } }
        }
    }
};
template <bool ADD> struct EpiMerge {
    static constexpr bool PERM = true, AFTER_DRAIN = false;
    const bf16* sg; bf16* mb;
    __device__ __forceinline__ void operator()(const f32x4 (&acc)[2][2][4][2], const Unit& u, int wr, int wc, int fr, int fq) const {
        const int row0 = u.pm * 256 + wr * 64 + fr, col0 = u.pn * 256 + wc * 32 + 8 * fq;
#pragma unroll
        for (int ai = 0; ai < 2; ++ai)
#pragma unroll
            for (int m = 0; m < 4; ++m)
#pragma unroll
                for (int bj = 0; bj < 2; ++bj) {
                    const size_t off = (size_t)(row0 + ai * 128 + m * 16) * DM + col0 + bj * 128;
                    const v4u s = *(const v4u*)(sg + off);
                    const f32x4 a0 = acc[ai][bj][m][0], a1 = acc[ai][bj][m][1];
                    float r[8] = {bflo(s.x) * a0[0], bfhi(s.x) * a0[1], bflo(s.y) * a0[2], bfhi(s.y) * a0[3], bflo(s.z) * a1[0], bfhi(s.z) * a1[1], bflo(s.w) * a1[2], bfhi(s.w) * a1[3]};
                    if (ADD) { const v4u o = *(const v4u*)(mb + off);
                        r[0] += bflo(o.x); r[1] += bfhi(o.x); r[2] += bflo(o.y); r[3] += bfhi(o.y); r[4] += bflo(o.z); r[5] += bfhi(o.z); r[6] += bflo(o.w); r[7] += bfhi(o.w); }
                    v4u w; w.x = pk2(r[0], r[1]); w.y = pk2(r[2], r[3]); w.z = pk2(r[4], r[5]); w.w = pk2(r[6], r[7]);
                    *(v4u*)(mb + off) = w;
                }
    }
};

__device__ __forceinline__ void p0_transpose_item(const float* W, int K, int N, bf16* WT, int ldt, int swiglu_perm, LAS float* scr, int item, int lane) {
    const int nblk = N / 32, kb = item / nblk, nb = item % nblk, k0 = 64 * kb, n0 = 32 * nb;
    int drow0 = n0;
    if (swiglu_perm) { const int half = N >> 1, isu = n0 >= half ? 1 : 0, j0 = n0 - isu * half; drow0 = (j0 >> 7) * 256 + isu * 128 + (j0 & 127); }
#pragma unroll 8
    for (int i = 0; i < 32; ++i) { const int kk = 2 * i + (lane >> 5); scr[kk * 33 + (lane & 31)] = W[(size_t)(k0 + kk) * N + n0 + (lane & 31)]; }
    LDS_WAIT(); asm volatile("" ::: "memory");
    const int c = lane & 7;
#pragma unroll
    for (int j = 0; j < 4; ++j) { const int n = (lane >> 3) + 8 * j; const LAS float* s = scr + (8 * c) * 33 + n;
        v4u o; o.x = pk2(s[0 * 33], s[1 * 33]); o.y = pk2(s[2 * 33], s[3 * 33]); o.z = pk2(s[4 * 33], s[5 * 33]); o.w = pk2(s[6 * 33], s[7 * 33]);
        *(GAS v4u*)(WT + (size_t)(drow0 + n) * ldt + k0 + 8 * c) = o; }
    LDS_WAIT(); asm volatile("" ::: "memory");
}
__device__ __forceinline__ void p0_mods_item(const float* c, const float* cctx, const float* w_mod, const float* b_mod, float* mods, LAS float* scr, int item, int lane) {
    const int cg = item >> 3, kc = item & 7, n = cg * 64 + lane, k0 = kc * 128;
#pragma unroll
    for (int r = 0; r < 9; ++r)
#pragma unroll
        for (int hf = 0; hf < 2; ++hf) { const int kk = lane + 64 * hf; const float cv = (r < 8) ? c[r * DM + k0 + kk] : cctx[k0 + kk]; scr[r * 128 + kk] = silu_f(cv); }
    LDS_WAIT(); asm volatile("" ::: "memory");
    float acc[9];
#pragma unroll
    for (int r = 0; r < 9; ++r) acc[r] = 0.f;
    const float* wp = w_mod + (size_t)k0 * NMODC + n;
#pragma unroll 4
    for (int kk = 0; kk < 128; kk += 4) {
        const float w0 = wp[(size_t)(kk + 0) * NMODC], w1 = wp[(size_t)(kk + 1) * NMODC], w2 = wp[(size_t)(kk + 2) * NMODC], w3 = wp[(size_t)(kk + 3) * NMODC];
#pragma unroll
        for (int r = 0; r < 9; ++r) { const f32x4 s = *(const LAS f32x4*)(scr + r * 128 + kk); acc[r] += s[0] * w0 + s[1] * w1 + s[2] * w2 + s[3] * w3; }
    }
    const float bm = (kc == 0) ? b_mod[n] : 0.f;
#pragma unroll
    for (int r = 0; r < 9; ++r) __hip_atomic_fetch_add(mods + (size_t)r * NMODC + n, acc[r] + bm, __ATOMIC_RELAXED, __HIP_MEMORY_SCOPE_AGENT);
    LDS_WAIT(); asm volatile("" ::: "memory");
}
__device__ __forceinline__ void p0_prep(const Frame& F, const Args& A) {
    LAS float* scr = (LAS float*)(F.lds + RING_OFF + F.wave * 16384);
    const int gw = blockIdx.x * NWAVES + F.wave, NGW = F.G * NWAVES, lane = F.lane;
    constexpr int N_MODS = 144 * 8;
    constexpr int N_FIN = (DM / 64) * (NFF / 32), N_FOUT = (DFF / 64) * (DM / 32), N_WIN = (DM / 64) * (INW / 32), N_WBA = (DATT / 64) * (DM / 32), N_WBL = (DLRU / 64) * (DM / 32), N_WOUT = (DM / 64) * (DM / 32);
    constexpr int N_WL = 2 * 2 * 16 * 2;
    constexpr int N_CVT = 64 * 8;
    constexpr int N_CK = 512;
    constexpr int N_BT = 8 * 15 * 4;
    constexpr int NITEMS = N_MODS + 2 * N_FIN + 2 * N_FOUT + N_WIN + N_WBA + N_WBL + N_WOUT + N_WL + N_CVT + N_CK + N_BT;
    for (int it = gw; it < NITEMS; it += NGW) {
        int r = it;
        if (r < N_MODS) { p0_mods_item(A.in[I_C], A.in[I_CCTX], A.in[I_WMOD], A.in[I_BMOD], WSF(F, WS_MODS), scr, r, lane); continue; } r -= N_MODS;
        if (r < N_FIN) { p0_transpose_item(A.in[I_F1IN], DM, NFF, WSB(F, WS_W1IN), DM, 1, scr, r, lane); continue; } r -= N_FIN;
        if (r < N_FIN) { p0_transpose_item(A.in[I_F2IN], DM, NFF, WSB(F, WS_W2IN), DM, 1, scr, r, lane); continue; } r -= N_FIN;
        if (r < N_WIN) { p0_transpose_item(A.in[I_WIN], DM, INW, WSB(F, WS_WIN), DM, 0, scr, r, lane); continue; } r -= N_WIN;
        if (r < N_FOUT) { p0_transpose_item(A.in[I_F1OUT], DFF, DM, WSB(F, WS_W1OUT), DFF, 0, scr, r, lane); continue; } r -= N_FOUT;
        if (r < N_FOUT) { p0_transpose_item(A.in[I_F2OUT], DFF, DM, WSB(F, WS_W2OUT), DFF, 0, scr, r, lane); continue; } r -= N_FOUT;
        if (r < N_WBA) { p0_transpose_item(A.in[I_WBRA], DATT, DM, WSB(F, WS_WBA), DATT, 0, scr, r, lane); continue; } r -= N_WBA;
        if (r < N_WBL) { p0_transpose_item(A.in[I_WBRL], DLRU, DM, WSB(F, WS_WBL), DLRU, 0, scr, r, lane); continue; } r -= N_WBL;
        if (r < N_WOUT) { p0_transpose_item(A.in[I_WOUT], DM, DM, WSB(F, WS_WOUT), DM, 0, scr, r, lane); continue; } r -= N_WOUT;
        if (r < N_WL) {
            const int blk = r >> 1, sub = r & 1, mat = blk >> 5, dn = blk & 31;
            const float* src = (mat == 0 ? A.in[I_LRUWA] : A.in[I_LRUWI]) + (size_t)dn * 4096;
            bf16* dst = WSB(F, WS_WL) + ((size_t)((dn >> 4) * 2 + mat) * 16 + (dn & 15)) * 4096;
            p0_transpose_item(src, 64, 64, dst, 64, 0, scr, sub, lane); continue; } r -= N_WL;
        if (r < N_CVT) { const int bh = r >> 3, sub = r & 7;
            p0_transpose_item(A.in[I_CACHE_V] + (size_t)bh * 256 * 64, 256, 64, WSB(F, WS_CVT) + (size_t)bh * 64 * 256, 256, 0, scr, sub, lane); continue; } r -= N_CVT;
        if (r < N_CK) { const float* ck = A.in[I_CACHE_K]; bf16* CK = WSB(F, WS_CK);
#pragma unroll
            for (int i = 0; i < 4; ++i) { const size_t idx = (size_t)r * 2048 + i * 512 + lane * 8; const f32x4 a = *(const f32x4*)(ck + idx), b = *(const f32x4*)(ck + idx + 4);
                v4u w; w.x = pk2(a[0], a[1]); w.y = pk2(a[2], a[3]); w.z = pk2(b[0], b[1]); w.w = pk2(b[2], b[3]); *(v4u*)(CK + idx) = w; }
            continue; } r -= N_CK;
        {
            const float* rpb = A.in[I_RPB]; float* BT = WSF(F, WS_BT);
            const int kt = r & 1, qt = (r >> 1) & 1, hd = r >> 2;
            const int qc = qt * 32 + (lane & 31), hh = lane >> 5;
            const int cs = min(max(qc - 8, 0), 48);
#pragma unroll
            for (int reg = 0; reg < 16; ++reg) { const int kcol = kt * 32 + crow(reg, hh);
                const bool inw = (kcol >= cs) && (kcol < cs + 16);
                const int dc = min(max(kcol - qc, -15), 15) + 15;
                BT[((size_t)r * 16 + reg) * 64 + lane] = inw ? rpb[(size_t)hd * 31 + dc] * LOG2E : -1e30f; }
        }
    }
}

template <int MODE> __device__ __forceinline__ void norm_phase(const Frame& F, const float* xctx, const float* xlat, const float* g, int ni, bf16* H, float* Y) {
    const int gw = blockIdx.x * NWAVES + F.wave, NGW = F.G * NWAVES, lane = F.lane;
    const float* mods = WSF(F, WS_MODS);
    for (int m = gw; m < MROWS; m += NGW) {
        const float* xrow = (m < MCTX) ? xctx + (size_t)m * DM : xlat + (size_t)(m - MCTX) * DM;
        const f32x4* xr = (const f32x4*)xrow + lane;
        f32x4 v[4]; float s = 0.f;
#pragma unroll
        for (int j = 0; j < 4; ++j) { v[j] = xr[64 * j]; s += (v[j][0] * v[j][0] + v[j][1] * v[j][1]) + (v[j][2] * v[j][2] + v[j][3] * v[j][3]); }
        const float rstd = 1.0f / sqrtf(wave_sum(s) * (1.f / DM) + EPS);
        if (MODE == 0) {
            const int mr = (m < MCTX) ? 8 : ((m - MCTX) >> 10);
            const float* sh = mods + (size_t)mr * NMODC + (3 * ni) * DM; const float* sc = sh + DM;
            unsigned long long* o8 = (unsigned long long*)(H + (size_t)m * DM) + lane;
#pragma unroll
            for (int j = 0; j < 4; ++j) { const int col = 4 * lane + 256 * j;
                const f32x4 gv = *(const f32x4*)(g + col), sv = *(const f32x4*)(sc + col), hv = *(const f32x4*)(sh + col);
                const f32x4 y = v[j] * rstd * gv * (sv + 1.0f) + hv;
                o8[64 * j] = (unsigned long long)pk2(y[0], y[1]) | ((unsigned long long)pk2(y[2], y[3]) << 32); }
        } else {
            f32x4* yr = (f32x4*)(Y + (size_t)m * DM) + lane;
#pragma unroll
            for (int j = 0; j < 4; ++j) { const int col = 4 * lane + 256 * j; const f32x4 gv = *(const f32x4*)(g + col); yr[64 * j] = v[j] * rstd * gv; }
        }
    }
}

__device__ __forceinline__ void conv_phase(const Frame& F, const float* conv_w, const float* conv_b) {
    const bf16* XL = WSB(F, WS_XL); bf16* XC = WSB(F, WS_H);
    const size_t nthreads = (size_t)F.G * NWAVES * 64, t0 = (size_t)blockIdx.x * NWAVES * 64 + F.tid;
    for (size_t it = t0; it < (size_t)MROWS * 128; it += nthreads) {
        const int row = (int)(it >> 7), cg = (int)(it & 127), c0 = cg * 8;
        int t, T; if (row < MCTX) { t = row & 255; T = TCTX; } else { t = (row - MCTX) & 1023; T = TLAT; }
        float acc[8];
        { const f32x4 b0 = *(const f32x4*)(conv_b + c0), b1 = *(const f32x4*)(conv_b + c0 + 4);
          acc[0] = b0[0]; acc[1] = b0[1]; acc[2] = b0[2]; acc[3] = b0[3]; acc[4] = b1[0]; acc[5] = b1[1]; acc[6] = b1[2]; acc[7] = b1[3]; }
#pragma unroll
        for (int j = 0; j < 4; ++j) { const int tt = t - 2 + j;
            if (tt >= 0 && tt < T) {
                const v4u x = *(const v4u*)(XL + (size_t)(row - 2 + j) * DM + c0);
                const f32x4 w0 = *(const f32x4*)(conv_w + j * DLRU + c0), w1 = *(const f32x4*)(conv_w + j * DLRU + c0 + 4);
                acc[0] += bflo(x.x) * w0[0]; acc[1] += bfhi(x.x) * w0[1]; acc[2] += bflo(x.y) * w0[2]; acc[3] += bfhi(x.y) * w0[3];
                acc[4] += bflo(x.z) * w1[0]; acc[5] += bfhi(x.z) * w1[1]; acc[6] += bflo(x.w) * w1[2]; acc[7] += bfhi(x.w) * w1[3]; } }
        v4u w; w.x = pk2(acc[0], acc[1]); w.y = pk2(acc[2], acc[3]); w.z = pk2(acc[4], acc[5]); w.w = pk2(acc[6], acc[7]);
        *(v4u*)(XC + (size_t)row * DM + c0) = w;
    }
}

#define MFMA16(a, b, c) __builtin_amdgcn_mfma_f32_16x16x32_bf16((a), (b), (c), 0, 0, 0)
#define MFMA32(a, b, c) __builtin_amdgcn_mfma_f32_32x32x16_bf16((a), (b), (c), 0, 0, 0)
#define LRU_GATE(pa, pi, xcv, kd, A_, B_) do { const float r_ = fast_sigmoid(pa), i_ = fast_sigmoid(pi); A_ = __builtin_amdgcn_exp2f(r_ * (kd)); \
    B_ = __builtin_amdgcn_sqrtf(fmaxf(1.f - A_ * A_, 0.f)) * (i_ * (xcv)); } while (0)
__device__ __forceinline__ void lru_unit(const Frame& F, const Args& A, int s, int n, int g, int lane) {
    const int d16 = lane & 15, q4 = lane >> 4;
    const int T = (s < 16) ? TCTX : TLAT, CL = T >> 2, NTL = CL >> 2;
    const int rb = (s < 16) ? s * TCTX : MCTX + (s - 16) * TLAT;
    const int ch = 64 * n + 16 * g + d16;
    const int qa = d16 >> 2, sa = d16 & 3;
    const bf16* xa = WSB(F, WS_H) + (size_t)(rb + qa * CL + sa) * DM + 64 * n + 8 * q4;
    const bf16* wb = WSB(F, WS_WL) + ((size_t)n * 64 + 16 * g + d16) * 64 + 8 * q4;
    bf16x8 Bid[2];
#pragma unroll
    for (int ks = 0; ks < 2; ++ks)
#pragma unroll
        for (int j = 0; j < 8; ++j) Bid[ks][j] = (32 * ks + 8 * q4 + j == 16 * g + d16) ? (short)0x3F80 : (short)0;
    const float baf = A.in[I_LRUBA][ch], bif = A.in[I_LRUBI][ch], bab = A.in[I_LRUBA][DLRU + ch], bib = A.in[I_LRUBI][DLRU + ch];
    const float kdf = -8.f * LOG2E * log1pf(expf(-A.in[I_LRULAM][ch])), kdb = -8.f * LOG2E * log1pf(expf(-A.in[I_LRULAM][DLRU + ch]));
    float h0f = 0.f, h0b = 0.f;
    if (s >= 16) { h0f = A.in[I_STATE][(size_t)((s - 16) * 2 + 0) * DLRU + ch]; h0b = A.in[I_STATE][(size_t)((s - 16) * 2 + 1) * DLRU + ch]; }
    const f32x4 z4 = {0.f, 0.f, 0.f, 0.f};
    float Hf, Hb;
    {
        bf16x8 Baf[2], Bif[2], Bab[2], Bib[2];
#pragma unroll
        for (int ks = 0; ks < 2; ++ks) { Baf[ks] = *(const bf16x8*)(wb + (size_t)(0 * 16) * 4096 + 32 * ks); Bif[ks] = *(const bf16x8*)(wb + (size_t)(1 * 16) * 4096 + 32 * ks);
            Bab[ks] = *(const bf16x8*)(wb + (size_t)(2 * 16) * 4096 + 32 * ks); Bib[ks] = *(const bf16x8*)(wb + (size_t)(3 * 16) * 4096 + 32 * ks); }
        float Pf = 1.f, Qf = 0.f, Pb = 1.f, Qb = 0.f;
        for (int j = 0; j < NTL; ++j) {
            const bf16x8 a0 = *(const bf16x8*)(xa + (size_t)(4 * j) * DM), a1 = *(const bf16x8*)(xa + (size_t)(4 * j) * DM + 32);
            f32x4 caf = MFMA16(a0, Baf[0], z4), cif = MFMA16(a0, Bif[0], z4), cab = MFMA16(a0, Bab[0], z4), cib = MFMA16(a0, Bib[0], z4), cx = MFMA16(a0, Bid[0], z4);
            caf = MFMA16(a1, Baf[1], caf); cif = MFMA16(a1, Bif[1], cif); cab = MFMA16(a1, Bab[1], cab); cib = MFMA16(a1, Bib[1], cib); cx = MFMA16(a1, Bid[1], cx);
#pragma unroll
            for (int r = 0; r < 4; ++r) { float a, b;
                LRU_GATE(caf[r] + baf, cif[r] + bif, cx[r], kdf, a, b); Qf = a * Qf + b; Pf *= a;
                LRU_GATE(cab[r] + bab, cib[r] + bib, cx[r], kdb, a, b); Qb = Qb + Pb * b; Pb *= a; }
        }
        { float h = h0f; Hf = h;
#pragma unroll
          for (int c = 0; c < 4; ++c) { const float p = __shfl(Pf, d16 + 16 * c), qq = __shfl(Qf, d16 + 16 * c); if (c == q4) Hf = h; h = p * h + qq; } }
        { float h = h0b; Hb = h;
#pragma unroll
          for (int c = 3; c >= 0; --c) { const float p = __shfl(Pb, d16 + 16 * c), qq = __shfl(Qb, d16 + 16 * c); if (c == q4) Hb = h; h = p * h + qq; } }
    }
    bf16* lo = WSB(F, WS_LO) + (size_t)(rb + q4 * CL) * DM + ch;
    const bf16* gg = WSB(F, WS_GG) + (size_t)(rb + q4 * CL) * DM + ch;
    {
        bf16x8 Ba[2], Bi[2];
#pragma unroll
        for (int ks = 0; ks < 2; ++ks) { Ba[ks] = *(const bf16x8*)(wb + (size_t)(0 * 16) * 4096 + 32 * ks); Bi[ks] = *(const bf16x8*)(wb + (size_t)(1 * 16) * 4096 + 32 * ks); }
        float h = Hf;
        for (int j = 0; j < NTL; ++j) {
            const bf16x8 a0 = *(const bf16x8*)(xa + (size_t)(4 * j) * DM), a1 = *(const bf16x8*)(xa + (size_t)(4 * j) * DM + 32);
            f32x4 ca = MFMA16(a0, Ba[0], z4), ci = MFMA16(a0, Bi[0], z4), cx = MFMA16(a0, Bid[0], z4);
            ca = MFMA16(a1, Ba[1], ca); ci = MFMA16(a1, Bi[1], ci); cx = MFMA16(a1, Bid[1], cx);
#pragma unroll
            for (int r = 0; r < 4; ++r) { float a, b; LRU_GATE(ca[r] + baf, ci[r] + bif, cx[r], kdf, a, b); h = a * h + b; lo[(size_t)(4 * j + r) * DM] = f2bf(h); }
        }
        if (s < 16 && q4 == 3) F.out[OUT_ST + (size_t)(s * 2 + 0) * DLRU + ch] = h;
    }
    {
        bf16x8 Ba[2], Bi[2];
#pragma unroll
        for (int ks = 0; ks < 2; ++ks) { Ba[ks] = *(const bf16x8*)(wb + (size_t)(2 * 16) * 4096 + 32 * ks); Bi[ks] = *(const bf16x8*)(wb + (size_t)(3 * 16) * 4096 + 32 * ks); }
        float h = Hb;
        for (int j = NTL - 1; j >= 0; --j) {
            const bf16x8 a0 = *(const bf16x8*)(xa + (size_t)(4 * j) * DM), a1 = *(const bf16x8*)(xa + (size_t)(4 * j) * DM + 32);
            f32x4 ca = MFMA16(a0, Ba[0], z4), ci = MFMA16(a0, Bi[0], z4), cx = MFMA16(a0, Bid[0], z4);
            ca = MFMA16(a1, Ba[1], ca); ci = MFMA16(a1, Bi[1], ci); cx = MFMA16(a1, Bid[1], cx);
#pragma unroll
            for (int r = 3; r >= 0; --r) { float a, b; LRU_GATE(ca[r] + bab, ci[r] + bib, cx[r], kdb, a, b); h = a * h + b;
                const size_t o = (size_t)(4 * j + r) * DM; const float y = (bf2f(lo[o]) + h) * bf2f(gg[o]); lo[o] = f2bf(y); }
        }
        if (s < 16 && q4 == 0) F.out[OUT_ST + (size_t)(s * 2 + 1) * DLRU + ch] = h;
    }
}

#define ATT_TILE(Kp, kpitch, VTp, vpitch, biasp) do { \
    f32x16 s_; \
    if (biasp) { _Pragma("unroll") for (int i_ = 0; i_ < 16; ++i_) s_[i_] = (biasp)[i_ * 64 + lane]; } \
    else { _Pragma("unroll") for (int i_ = 0; i_ < 16; ++i_) s_[i_] = 0.f; } \
    _Pragma("unroll") for (int ks_ = 0; ks_ < 4; ++ks_) { const bf16x8 kf_ = *(const bf16x8*)((Kp) + (size_t)r32 * (kpitch) + 16 * ks_ + 8 * hh); s_ = MFMA32(kf_, qf[ks_], s_); } \
    float tm_ = fmaxf(fmaxf(s_[0], s_[1]), fmaxf(s_[2], s_[3])); \
    _Pragma("unroll") for (int i_ = 4; i_ < 16; i_ += 4) tm_ = fmaxf(tm_, fmaxf(fmaxf(s_[i_], s_[i_ + 1]), fmaxf(s_[i_ + 2], s_[i_ + 3]))); \
    tm_ = fmaxf(tm_, __shfl_xor(tm_, 32)); \
    const float mn_ = fmaxf(mrun, tm_); const float al_ = __builtin_amdgcn_exp2f(mrun - mn_); mrun = mn_; \
    float ps_ = 0.f; \
    _Pragma("unroll") for (int i_ = 0; i_ < 16; ++i_) { s_[i_] = __builtin_amdgcn_exp2f(s_[i_] - mn_); ps_ += s_[i_]; } \
    lrun = lrun * al_ + ps_; \
    _Pragma("unroll") for (int i_ = 0; i_ < 16; ++i_) { o0[i_] *= al_; o1[i_] *= al_; } \
    v4u pa_, pb_; \
    pa_.x = pk2(s_[0], s_[1]); pa_.y = pk2(s_[2], s_[3]); pa_.z = pk2(s_[4], s_[5]); pa_.w = pk2(s_[6], s_[7]); \
    pb_.x = pk2(s_[8], s_[9]); pb_.y = pk2(s_[10], s_[11]); pb_.z = pk2(s_[12], s_[13]); pb_.w = pk2(s_[14], s_[15]); \
    const bf16x8 p0_ = __builtin_bit_cast(bf16x8, pa_), p1_ = __builtin_bit_cast(bf16x8, pb_); \
    { const bf16* vp_ = (VTp) + (size_t)r32 * (vpitch) + 4 * hh; \
      s16x4 l0_ = *(const s16x4*)vp_, h0_ = *(const s16x4*)(vp_ + 8), l1_ = *(const s16x4*)(vp_ + 16), h1_ = *(const s16x4*)(vp_ + 24); \
      o0 = MFMA32(__builtin_shufflevector(l0_, h0_, 0, 1, 2, 3, 4, 5, 6, 7), p0_, o0); \
      o0 = MFMA32(__builtin_shufflevector(l1_, h1_, 0, 1, 2, 3, 4, 5, 6, 7), p1_, o0); \
      const bf16* vq_ = vp_ + (size_t)32 * (vpitch); \
      s16x4 l2_ = *(const s16x4*)vq_, h2_ = *(const s16x4*)(vq_ + 8), l3_ = *(const s16x4*)(vq_ + 16), h3_ = *(const s16x4*)(vq_ + 24); \
      o1 = MFMA32(__builtin_shufflevector(l2_, h2_, 0, 1, 2, 3, 4, 5, 6, 7), p0_, o1); \
      o1 = MFMA32(__builtin_shufflevector(l3_, h3_, 0, 1, 2, 3, 4, 5, 6, 7), p1_, o1); } \
} while (0)

__device__ __forceinline__ void attn_unit(const Frame& F, int type, int b, int h, int qt, int lane) {
    const int r32 = lane & 31, hh = lane >> 5;
    const int qrow = (type == 0) ? b * TCTX + qt * 32 + r32 : MCTX + b * TLAT + qt * 32 + r32;
    bf16x8 qf[4];
#pragma unroll
    for (int ks = 0; ks < 4; ++ks) qf[ks] = *(const bf16x8*)(WSB(F, WS_Q) + (size_t)qrow * DATT + h * 64 + 16 * ks + 8 * hh);
    f32x16 o0, o1;
#pragma unroll
    for (int i = 0; i < 16; ++i) { o0[i] = 0.f; o1[i] = 0.f; }
    float mrun = -1e30f, lrun = 0.f;
    const float* nobias = nullptr;
    if (type == 0) {
        const bf16* Kb = WSB(F, WS_K) + (size_t)(b * TCTX) * DATT + h * 64;
        const bf16* Vb = WSB(F, WS_VT) + (size_t)(b * 8 + h) * 64 * TCTX;
        for (int kt = 0; kt < 8; ++kt) ATT_TILE(Kb + (size_t)(kt * 32) * DATT, DATT, Vb + kt * 32, TCTX, nobias);
    } else {
        const bf16* Kc = WSB(F, WS_CK) + (size_t)(b * 8 + h) * 256 * 64;
        const bf16* Vc = WSB(F, WS_CVT) + (size_t)(b * 8 + h) * 64 * 256;
        for (int kt = 0; kt < 8; ++kt) ATT_TILE(Kc + (size_t)(kt * 32) * 64, 64, Vc + kt * 32, 256, nobias);
        const int r = qt >> 1, qh = qt & 1, rs = min(max(r - 4, 0), 8);
        const bf16* Kb = WSB(F, WS_K) + (size_t)(MCTX + b * TLAT) * DATT + h * 64;
        const bf16* Vb = WSB(F, WS_VT) + VT_LAT_OFF + (size_t)(b * 8 + h) * 64 * TLAT;
        const float* BT = WSF(F, WS_BT);
        for (int kk = 0; kk < 16; ++kk) { const int kr = rs + (kk >> 1), kc = kk & 1, tok = kr * 64 + kc * 32;
            const float* bp = BT + ((size_t)(((h * 15 + (kr - r + 7)) * 2 + qh) * 2 + kc)) * 1024;
            ATT_TILE(Kb + (size_t)tok * DATT, DATT, Vb + tok, TLAT, bp); }
    }
    const float lt = lrun + __shfl_xor(lrun, 32);
    const float inv = 1.f / lt;
    bf16* op = WSB(F, WS_AO) + (size_t)qrow * DATT + h * 64 + 4 * hh;
#pragma unroll
    for (int g4 = 0; g4 < 4; ++g4) {
        v2u w0, w1;
        w0.x = pk2(o0[4 * g4] * inv, o0[4 * g4 + 1] * inv); w0.y = pk2(o0[4 * g4 + 2] * inv, o0[4 * g4 + 3] * inv);
        w1.x = pk2(o1[4 * g4] * inv, o1[4 * g4 + 1] * inv); w1.y = pk2(o1[4 * g4 + 2] * inv, o1[4 * g4 + 3] * inv);
        *(v2u*)(op + 8 * g4) = w0; *(v2u*)(op + 32 + 8 * g4) = w1;
    }
}

__device__ __forceinline__ void mixing_phase(const Frame& F, const Args& A) {
    const int lane = F.lane, wave = F.wave;
    constexpr int N_LRU_LONG = 8 * 64, N_LRU_SHORT = 16 * 64, N_NA = 8 * 8 * 32, N_CA = 16 * 8 * 8;
    if (wave < 2) {
        for (int u = blockIdx.x * 2 + wave; u < N_LRU_LONG; u += F.G * 2) { const int s = 16 + (u >> 6), ng = u & 63; lru_unit(F, A, s, ng >> 2, ng & 3, lane); }
    } else {
        const int slot = blockIdx.x * 6 + (wave - 2), nslot = F.G * 6;
        for (int u = slot; u < N_LRU_SHORT + N_NA + N_CA; u += nslot) {
            int r = u;
            if (r < N_LRU_SHORT) { const int s = r >> 6, ng = r & 63; lru_unit(F, A, s, ng >> 2, ng & 3, lane); continue; } r -= N_LRU_SHORT;
            if (r < N_NA) { attn_unit(F, 1, r >> 8, (r >> 5) & 7, r & 31, lane); continue; } r -= N_NA;
            attn_unit(F, 0, r >> 6, (r >> 3) & 7, r & 7, lane);
        }
    }
}

__global__ void __launch_bounds__(NWAVES * 64, 2) hybrid_fwd(Args args) {
    extern __shared__ __attribute__((aligned(16))) unsigned char lds[];
    Frame F;
    F.lds = (LAS unsigned char*)lds;
    F.tid = threadIdx.x; F.lane = F.tid & 63; F.wave = __builtin_amdgcn_readfirstlane(F.tid >> 6); F.G = gridDim.x;
    F.ws = args.ws; F.out = args.out;
    for (int u = F.tid; u < (LDS_BYTES - LDSCTL_OFF) / 4; u += NWAVES * 64) ((LAS unsigned*)(F.lds + LDSCTL_OFF))[u] = 0u;
    __syncthreads();
    volatile LAS unsigned* MISC = (volatile LAS unsigned*)(F.lds + MISC_OFF);
    XcdBarrier bar; bar.bar = (unsigned*)(F.ws + WS_CTL) + CW_BAR; bar.x = 0; bar.st = nullptr;
    const bool use_bar = (args.ph_hi - args.ph_lo) > 1;
    if (use_bar) bar = xcd_barrier_post((unsigned*)(F.ws + WS_CTL) + CW_BAR, MISC + 8);
    const int lo = args.ph_lo, hi = args.ph_hi;
#define IN(k) (lo <= (k) && (k) < hi)
#define SEAM(k) do { if ((k) + 1 < hi) xcd_barrier(bar); } while (0)
    float* const xres = F.out + OUT_Y;
    float* const xres_lat = xres + (size_t)MCTX * DM;

    if (IN(0)) { p0_prep(F, args); SEAM(0); }
    if (IN(1)) { norm_phase<0>(F, args.in[I_XP], args.in[I_XS], args.in[I_NORMG], 0, WSB(F, WS_H), nullptr); SEAM(1); }
    if (IN(2)) {
        pg8::Gemm g{WSB(F, WS_H), WSB(F, WS_W1IN), MROWS, NFF, DM}; pg8::StaticOrder S; S.init(MROWS, NFF, F.G, (int)blockIdx.x);
        EpiSwiglu E{WSB(F, WS_ACT)};
        pg8::gemm_phase<EpiSwiglu, pg8::StaticOrder, true, true>(F.lds + RING_OFF, g, S, E); SEAM(2); }
    if (IN(3)) {
        pg8::Gemm g{WSB(F, WS_ACT), WSB(F, WS_W1OUT), MROWS, DM, DFF}; pg8::StaticOrder S; S.init(MROWS, DM, F.G, (int)blockIdx.x);
        EpiResid E{args.in[I_XP], args.in[I_XS], xres, WSF(F, WS_MODS) + 2 * DM, 0.5f};
        pg8::gemm_phase<EpiResid, pg8::StaticOrder, true, true>(F.lds + RING_OFF, g, S, E); SEAM(3); }
    if (IN(4)) { norm_phase<0>(F, xres, xres_lat, args.in[I_NORMG] + DM, 1, WSB(F, WS_H), nullptr); SEAM(4); }
    if (IN(5)) {
        pg8::Gemm g{WSB(F, WS_H), WSB(F, WS_WIN), MROWS, INW, DM}; pg8::StaticOrder S; S.init(MROWS, INW, F.G, (int)blockIdx.x);
        EpiInProj E{WSB(F, WS_Q), WSB(F, WS_VT), WSB(F, WS_XL), F.out + OUT_CK};
        pg8::gemm_phase<EpiInProj, pg8::StaticOrder, true, true>(F.lds + RING_OFF, g, S, E); SEAM(5); }
    if (IN(6)) { conv_phase(F, args.in[I_CONVW], args.in[I_CONVB]); SEAM(6); }
    if (IN(7)) { mixing_phase(F, args); SEAM(7); }
    if (IN(8)) {
        pg8::StaticOrder S; S.init(MROWS, DM, F.G, (int)blockIdx.x);
        { pg8::Gemm g{WSB(F, WS_AO), WSB(F, WS_WBA), MROWS, DM, DATT}; EpiMerge<false> E{WSB(F, WS_SGA), WSB(F, WS_H)};
          pg8::gemm_phase<EpiMerge<false>, pg8::StaticOrder, true, true>(F.lds + RING_OFF, g, S, E); }
        { pg8::Gemm g{WSB(F, WS_LO), WSB(F, WS_WBL), MROWS, DM, DLRU}; EpiMerge<true> E{WSB(F, WS_SGB), WSB(F, WS_H)};
          pg8::gemm_phase<EpiMerge<true>, pg8::StaticOrder, true, true>(F.lds + RING_OFF, g, S, E); }
        SEAM(8); }
    if (IN(9)) {
        pg8::Gemm g{WSB(F, WS_H), WSB(F, WS_WOUT), MROWS, DM, DM}; pg8::StaticOrder S; S.init(MROWS, DM, F.G, (int)blockIdx.x);
        EpiResid E{xres, xres_lat, xres, WSF(F, WS_MODS) + 5 * DM, 1.0f};
        pg8::gemm_phase<EpiResid, pg8::StaticOrder, true, true>(F.lds + RING_OFF, g, S, E); SEAM(9); }
    if (IN(10)) { norm_phase<0>(F, xres, xres_lat, args.in[I_NORMG] + 2 * DM, 2, WSB(F, WS_H), nullptr); SEAM(10); }
    if (IN(11)) {
        pg8::Gemm g{WSB(F, WS_H), WSB(F, WS_W2IN), MROWS, NFF, DM}; pg8::StaticOrder S; S.init(MROWS, NFF, F.G, (int)blockIdx.x);
        EpiSwiglu E{WSB(F, WS_ACT)};
        pg8::gemm_phase<EpiSwiglu, pg8::StaticOrder, true, true>(F.lds + RING_OFF, g, S, E); SEAM(11); }
    if (IN(12)) {
        pg8::Gemm g{WSB(F, WS_ACT), WSB(F, WS_W2OUT), MROWS, DM, DFF}; pg8::StaticOrder S; S.init(MROWS, DM, F.G, (int)blockIdx.x);
        EpiResid E{xres, xres_lat, xres, WSF(F, WS_MODS) + 8 * DM, 0.5f};
        pg8::gemm_phase<EpiResid, pg8::StaticOrder, true, true>(F.lds + RING_OFF, g, S, E); SEAM(12); }
    if (IN(13)) { norm_phase<1>(F, xres, xres_lat, args.in[I_FINALG], 0, nullptr, xres); }
#undef IN
#undef SEAM
}

extern "C" void kernel_launch(void* const* d_in, const int* in_sizes, int n_in, void* d_out, int out_size, void* d_ws, size_t ws_size, hipStream_t stream) {
    static int grid = 0;
    if (grid == 0) {
        if (n_in != 27 || ws_size < WS_END) { fprintf(stderr, "kernel_launch: unexpected inputs (n_in %d, ws %zu)\n", n_in, ws_size); grid = -1; return; }
        int dev = 0, cus = 0, per_cu = 0;
        if (hipGetDevice(&dev) != hipSuccess || hipDeviceGetAttribute(&cus, hipDeviceAttributeMultiprocessorCount, dev) != hipSuccess) { grid = -1; return; }
        if (hipFuncSetAttribute((const void*)hybrid_fwd, hipFuncAttributeMaxDynamicSharedMemorySize, LDS_BYTES) != hipSuccess) { fprintf(stderr, "kernel_launch: hipFuncSetAttribute failed\n"); grid = -1; return; }
        if (hipOccupancyMaxActiveBlocksPerMultiprocessor(&per_cu, (const void*)hybrid_fwd, NWAVES * 64, LDS_BYTES) != hipSuccess || per_cu < 1)
            fprintf(stderr, "kernel_launch: note: occupancy query reports %d workgroups per CU\n", per_cu);
        (void)hipGetLastError();
        grid = cus;
    }
    if (grid < 0) return;
    if (hipMemsetAsync((char*)d_ws + WS_CTL, 0, CTL_ZERO_BYTES, stream) != hipSuccess) { fprintf(stderr, "kernel_launch: memset failed\n"); return; }
    Args a{};
    for (int i = 0; i < 27; ++i) a.in[i] = (const float*)d_in[i];
    a.out = (float*)d_out; a.ws = (unsigned char*)d_ws;
    constexpr int NL = MK_N_LAUNCHES;
    for (int li = 0; li < NL; ++li) {
        a.ph_lo = (NL == 1) ? 0 : li; a.ph_hi = (NL == 1) ? NPH : li + 1; a.li = 0;
        hipLaunchKernelGGL(hybrid_fwd, dim3(grid), dim3(NWAVES * 64), LDS_BYTES, stream, a);
        const hipError_t le = hipPeekAtLastError();
        if (le != hipSuccess) { fprintf(stderr, "kernel_launch: launch %d failed: %s\n", li, hipGetErrorName(le)); break; }
    }
}
```

```cpp
#include <hip/hip_runtime.h>
#include <cstdio>
#include <cstdint>

#ifndef MK_N_LAUNCHES
#define MK_N_LAUNCHES 1
#endif

namespace pg8 {
#define PG8_LAS __attribute__((address_space(3)))
typedef unsigned short bf16_t;
typedef short bf16x8 __attribute__((ext_vector_type(8)));
typedef float f32x4 __attribute__((ext_vector_type(4)));
typedef unsigned u32x4 __attribute__((ext_vector_type(4)));
constexpr int BM = 256, BK = 64, HALF = 128, HTB = HALF * BK * 2, STAGE_BYTES = 8 * HTB, NXCD = 8, WGM = 8;

__host__ __device__ __forceinline__ int lds_byte(int r, int c) { const int st = (r >> 4) * 2 + (c >> 5), rr = r & 15, cc = c & 31, ob = rr * 64 + cc * 2; return st * 1024 + (ob ^ (((ob >> 9) & 1) << 5)); }
__host__ __device__ __forceinline__ void stage_rc(int b, int& R, int& C) { const int st = b / 1024, sb = b % 1024, swz = sb ^ (((sb >> 9) & 1) << 5); R = (st >> 1) * 16 + swz / 64; C = (st & 1) * 32 + (swz % 64) / 2; }
__host__ __device__ __forceinline__ int perm32(int rho) { const int n = rho >> 4, i = rho & 15; return 8 * (i >> 2) + 4 * n + (i & 3); }

struct Unit { int pm, pn; };
struct Gemm { const bf16_t* A; const bf16_t* Bt; int M, N, K; };

struct StaticOrder {
    int nM, nN, nwg, G, c;
    __host__ __device__ void init(int M, int N, int G_, int c_) { nM = M / BM; nN = N / BM; nwg = nM * nN; G = G_; c = c_; }
    __host__ __device__ bool next(int i, Unit& u) const {
        const long L = (long)i * G + c; if (L >= nwg) return false;
        int wgid = (int)L; { const int q = nwg / NXCD, r = nwg % NXCD, xcd = wgid % NXCD, off = wgid / NXCD; wgid = (xcd < r ? xcd * (q + 1) : r * (q + 1) + (xcd - r) * q) + off; }
        const int nig = WGM * nN, gid = wgid / nig, fm = gid * WGM, gsz = (nM - fm) < WGM ? (nM - fm) : WGM;
        u.pm = fm + ((wgid % nig) % gsz); u.pn = (wgid % nig) / gsz; return true;
    }
    __device__ __forceinline__ void a_ready(const Unit&) const {}
    __device__ __forceinline__ void done(const Unit&) const {}
};

template <class Epi, class Sched, bool ALIGN_EPI = false, bool SP2 = false>
__device__ __forceinline__ void gemm_phase(PG8_LAS unsigned char* lds, const Gemm g, const Sched& S, const Epi& E) {
    const int tid = threadIdx.x, wid = __builtin_amdgcn_readfirstlane(tid >> 6), lane = tid & 63, wr = wid >> 2, wc = wid & 3, fr = lane & 15, fq = lane >> 4;
    const int K = g.K, nt = K / BK;
    unsigned voffA[2], voffB[2];
#pragma unroll
    for (int i = 0; i < 2; ++i) { int R, C; stage_rc(tid * 16 + i * 8192, R, C); const int Rb = Epi::PERM ? ((R & ~31) + perm32(R & 31)) : R;
        voffA[i] = (unsigned)(R * K + C) * 2u; voffB[i] = (unsigned)(Rb * K + C) * 2u; }
    const size_t kstep = (size_t)(BK * 2);
    const size_t hstep = (size_t)HALF * K * 2;
    const size_t tstep = 2 * hstep;
    const unsigned ldsw = (unsigned)wid * 1024u;
    const int aoff = lds_byte(wr * 64 + fr, fq * 8), boff = lds_byte(wc * 32 + fr, fq * 8);
#define PG8_SA(b, h) (((b) * 2 + (h)) * HTB)
#define PG8_SB(b, h) ((4 + (b) * 2 + (h)) * HTB)
#define PG8_STAGE(bufoff, gbase, voff) do { _Pragma("unroll") for (int _i = 0; _i < 2; ++_i) \
        __builtin_amdgcn_global_load_lds((const unsigned*)((const char*)(gbase) + (voff)[_i]), (PG8_LAS unsigned*)(lds + (bufoff) + ldsw + _i * 8192), 16, 0, 0); } while (0)
#define PG8_LDA(dst, b, h) do { _Pragma("unroll") for (int m = 0; m < 4; ++m) _Pragma("unroll") for (int k = 0; k < 2; ++k) dst[m][k] = *(const PG8_LAS bf16x8*)(lds + PG8_SA(b, h) + aoff + m * 2048 + k * 1024); } while (0)
#define PG8_LDB(dst, b, h) do { _Pragma("unroll") for (int n = 0; n < 2; ++n) _Pragma("unroll") for (int k = 0; k < 2; ++k) dst[n][k] = *(const PG8_LAS bf16x8*)(lds + PG8_SB(b, h) + boff + n * 2048 + k * 1024); } while (0)
#define PG8_MMA(ai, bj, At, Bt) do { __builtin_amdgcn_s_setprio(1); _Pragma("unroll") for (int m = 0; m < 4; ++m) _Pragma("unroll") for (int n = 0; n < 2; ++n) _Pragma("unroll") for (int k = 0; k < 2; ++k) \
        acc[ai][bj][m][n] = __builtin_amdgcn_mfma_f32_16x16x32_bf16(Bt[n][k], At[m][k], acc[ai][bj][m][n], 0, 0, 0); __builtin_amdgcn_s_setprio(0); } while (0)
#define PG8_WAIT_V(n) asm volatile("s_waitcnt vmcnt(" #n ")" ::: "memory")
#define PG8_WAIT_L(n) asm volatile("s_waitcnt lgkmcnt(" #n ")" ::: "memory")
#define PG8_BAR __builtin_amdgcn_s_barrier()
#define PG8_SCHED __builtin_amdgcn_sched_barrier(0)
    Unit cur, nxt; int ui = 0;
    if (!S.next(0, cur)) return;
    f32x4 acc[2][2][4][2];
#pragma unroll
    for (int a = 0; a < 2; ++a)
#pragma unroll
        for (int b = 0; b < 2; ++b)
#pragma unroll
            for (int m = 0; m < 4; ++m)
#pragma unroll
                for (int n = 0; n < 2; ++n) acc[a][b][m][n] = (f32x4){0.f, 0.f, 0.f, 0.f};
    bf16x8 At[4][2], B0[2][2], B1[2][2];
    const char* cA = (const char*)g.A + (size_t)cur.pm * tstep; const char* cB = (const char*)g.Bt + (size_t)cur.pn * tstep;
    S.a_ready(cur);
    if constexpr (SP2) {
        PG8_STAGE(PG8_SB(0, 0), cB, voffB); PG8_STAGE(PG8_SB(0, 1), cB + hstep, voffB); PG8_STAGE(PG8_SA(0, 0), cA, voffA); PG8_STAGE(PG8_SA(0, 1), cA + hstep, voffA);
        if (wr == 1) PG8_BAR;
        PG8_WAIT_V(2); PG8_BAR;
        PG8_STAGE(PG8_SB(1, 0), cB + kstep, voffB); PG8_STAGE(PG8_SA(1, 0), cA + kstep, voffA); PG8_STAGE(PG8_SB(1, 1), cB + hstep + kstep, voffB);
        PG8_WAIT_V(6); PG8_BAR;
    } else {
        PG8_STAGE(PG8_SB(0, 0), cB, voffB); PG8_STAGE(PG8_SA(0, 0), cA, voffA); PG8_STAGE(PG8_SB(0, 1), cB + hstep, voffB); PG8_STAGE(PG8_SA(0, 1), cA + hstep, voffA);
        if (wr == 1) PG8_BAR;
        PG8_WAIT_V(4); PG8_BAR;
        PG8_STAGE(PG8_SB(1, 0), cB + kstep, voffB); PG8_STAGE(PG8_SA(1, 0), cA + kstep, voffA); PG8_STAGE(PG8_SB(1, 1), cB + hstep + kstep, voffB);
        PG8_WAIT_V(6); PG8_BAR;
    }
    for (;;) {
        const bool has_next = S.next(ui + 1, nxt);
        const char* nA = has_next ? (const char*)g.A + (size_t)nxt.pm * tstep : cA; const char* nB = has_next ? (const char*)g.Bt + (size_t)nxt.pn * tstep : cB;
        for (int t = 0; t < nt; t += 2) {
            const bool last = (t == nt - 2);
            const char* a1 = cA + (size_t)(t + 1) * kstep;
            const char* a2 = last ? nA : cA + (size_t)(t + 2) * kstep; const char* b2 = last ? nB : cB + (size_t)(t + 2) * kstep;
            const char* a3 = a2 + kstep; const char* b3 = b2 + kstep;
            if (last && has_next) S.a_ready(nxt);
            if constexpr (SP2) {
            PG8_LDB(B0, 0, 0); PG8_LDB(B1, 0, 1); PG8_SCHED; PG8_LDA(At, 0, 0); PG8_STAGE(PG8_SA(1, 1), a1 + hstep, voffA);
            PG8_WAIT_V(8); PG8_WAIT_L(0); PG8_BAR; PG8_MMA(0, 0, At, B0); PG8_MMA(0, 1, At, B1); PG8_BAR; PG8_SCHED;
            PG8_LDA(At, 0, 1); PG8_STAGE(PG8_SB(0, 0), b2, voffB); PG8_STAGE(PG8_SB(0, 1), b2 + hstep, voffB); PG8_STAGE(PG8_SA(0, 0), a2, voffA);
            PG8_WAIT_V(8); PG8_WAIT_L(0); PG8_BAR; PG8_MMA(1, 0, At, B0); PG8_MMA(1, 1, At, B1); PG8_BAR; PG8_SCHED;
            PG8_LDB(B0, 1, 0); PG8_LDB(B1, 1, 1); PG8_SCHED; PG8_LDA(At, 1, 0); PG8_STAGE(PG8_SA(0, 1), a2 + hstep, voffA);
            PG8_WAIT_V(8); PG8_WAIT_L(0); PG8_BAR; PG8_MMA(0, 0, At, B0); PG8_MMA(0, 1, At, B1); PG8_BAR; PG8_SCHED;
            PG8_LDA(At, 1, 1); PG8_STAGE(PG8_SB(1, 0), b3, voffB); PG8_STAGE(PG8_SB(1, 1), b3 + hstep, voffB); PG8_STAGE(PG8_SA(1, 0), a3, voffA);
            PG8_WAIT_V(8); PG8_WAIT_L(0); PG8_BAR; PG8_MMA(1, 0, At, B0); PG8_MMA(1, 1, At, B1); PG8_BAR; PG8_SCHED;
            } else {
            PG8_LDB(B0, 0, 0); PG8_SCHED; PG8_LDA(At, 0, 0); PG8_STAGE(PG8_SA(1, 1), a1 + hstep, voffA);
            PG8_WAIT_L(8); PG8_BAR; PG8_WAIT_L(0); PG8_MMA(0, 0, At, B0); PG8_BAR; PG8_SCHED;
            PG8_LDB(B1, 0, 1); PG8_STAGE(PG8_SB(0, 0), b2, voffB);
            PG8_BAR; PG8_WAIT_L(0); PG8_MMA(0, 1, At, B1); PG8_BAR;
            PG8_LDA(At, 0, 1); PG8_STAGE(PG8_SA(0, 0), a2, voffA);
            PG8_BAR; PG8_WAIT_L(0); PG8_MMA(1, 0, At, B0); PG8_BAR; PG8_SCHED;
            PG8_STAGE(PG8_SB(0, 1), b2 + hstep, voffB);
            PG8_WAIT_V(6); PG8_BAR; PG8_MMA(1, 1, At, B1); PG8_BAR;
            PG8_LDB(B0, 1, 0); PG8_SCHED; PG8_LDA(At, 1, 0); PG8_STAGE(PG8_SA(0, 1), a2 + hstep, voffA);
            PG8_WAIT_L(8); PG8_BAR; PG8_WAIT_L(0); PG8_MMA(0, 0, At, B0); PG8_BAR; PG8_SCHED;
            PG8_LDB(B1, 1, 1); PG8_STAGE(PG8_SB(1, 0), b3, voffB);
            PG8_BAR; PG8_WAIT_L(0); PG8_MMA(0, 1, At, B1); PG8_BAR;
            PG8_LDA(At, 1, 1); PG8_STAGE(PG8_SA(1, 0), a3, voffA);
            PG8_BAR; PG8_WAIT_L(0); PG8_MMA(1, 0, At, B0); PG8_BAR; PG8_SCHED;
            PG8_STAGE(PG8_SB(1, 1), b3 + hstep, voffB);
            PG8_WAIT_V(6); PG8_BAR; PG8_MMA(1, 1, At, B1); PG8_BAR;
            }
        }
        if constexpr (ALIGN_EPI) { if (wr == 0) PG8_BAR; }
        E(acc, cur, wr, wc, fr, fq); S.done(cur);
        if (!has_next) break;
#pragma unroll
        for (int a = 0; a < 2; ++a)
#pragma unroll
            for (int b = 0; b < 2; ++b)
#pragma unroll
                for (int m = 0; m < 4; ++m)
#pragma unroll
                    for (int n = 0; n < 2; ++n) acc[a][b][m][n] = (f32x4){0.f, 0.f, 0.f, 0.f};
        cur = nxt; cA = nA; cB = nB; ++ui;
        if constexpr (ALIGN_EPI) { if (wr == 1) PG8_BAR; }
    }
    PG8_WAIT_V(0);
    if constexpr (!ALIGN_EPI) { if (wr == 0) PG8_BAR; }
    PG8_BAR;
#undef PG8_SA
#undef PG8_SB
#undef PG8_STAGE
#undef PG8_LDA
#undef PG8_LDB
#undef PG8_MMA
#undef PG8_WAIT_V
#undef PG8_WAIT_L
#undef PG8_BAR
#undef PG8_SCHED
}
}

constexpr int NWAVES = 8;
constexpr int DM = 1024, NCTXB = 16, TCTX = 256, NLATB = 8, TLAT = 1024;
constexpr int MCTX = NCTXB * TCTX  , MLAT = NLATB * TLAT  , MROWS = MCTX + MLAT  ;
constexpr int DFF = 2816, NFF = 2 * DFF  , INW = 5632, DATT = 512, DLRU = 1024, NMODC = 9 * DM  ;
constexpr float EPS = 1e-6f;
constexpr float LOG2E = 1.4426950408889634f;
constexpr float QSCALE = 0.125f * LOG2E;
constexpr int NPH = 14;

constexpr size_t MiB = 1u << 20, HMiB = 1u << 19;
constexpr size_t WS_CTL = 0, CTL_ZERO_BYTES = 1 * MiB;
constexpr size_t WS_MODS = HMiB;
constexpr size_t WS_BT = 2 * MiB;
constexpr size_t WS_W1IN = 4 * MiB, WS_W1OUT = 15 * MiB, WS_WIN = 20 * MiB + HMiB, WS_WBA = 31 * MiB + HMiB, WS_WBL = 32 * MiB + HMiB,
                 WS_WOUT = 34 * MiB + HMiB, WS_W2IN = 36 * MiB + HMiB, WS_W2OUT = 47 * MiB + HMiB, WS_WL = 53 * MiB, WS_CK = 54 * MiB, WS_CVT = 56 * MiB;
constexpr size_t WS_H = 58 * MiB;
constexpr size_t WS_ACT = 82 * MiB;
constexpr size_t WS_Q = 82 * MiB, WS_K = 94 * MiB, WS_VT = 106 * MiB, WS_XL = 118 * MiB, WS_GG = 142 * MiB, WS_SGA = 166 * MiB, WS_SGB = 190 * MiB;
constexpr size_t WS_AO = 214 * MiB, WS_LO = 226 * MiB, WS_END = 250 * MiB;
static_assert(WS_SGA - WS_GG == WS_GG - WS_XL && WS_SGB - WS_SGA == WS_GG - WS_XL, "xl/gg/sga/sgb equally spaced");
constexpr size_t VT_LAT_OFF = (size_t)NCTXB * 8 * 64 * TCTX;
constexpr int CW_TMO = 0, CW_BAR = 4096;

constexpr size_t OUT_Y = 0, OUT_CK = (size_t)MROWS * DM, OUT_CV = OUT_CK + (size_t)NCTXB * 8 * TCTX * 64, OUT_ST = OUT_CV + (size_t)NCTXB * 8 * TCTX * 64;

constexpr int RING_OFF = 0, RING_BYTES = 131072;
constexpr int LDSCTL_OFF = RING_BYTES, MISC_OFF = LDSCTL_OFF + 320;
constexpr int LDS_BYTES = 147456;

#define GAS __attribute__((address_space(1)))
#define LAS __attribute__((address_space(3)))
typedef unsigned short bf16;
typedef unsigned v4u __attribute__((ext_vector_type(4)));
typedef unsigned v2u __attribute__((ext_vector_type(2)));
typedef float f32x4 __attribute__((ext_vector_type(4)));
typedef float f32x16 __attribute__((ext_vector_type(16)));
typedef short bf16x8 __attribute__((ext_vector_type(8)));
typedef short s16x4 __attribute__((ext_vector_type(4)));
typedef GAS unsigned gu32;
#define RLX_AGENT __ATOMIC_RELAXED, __HIP_MEMORY_SCOPE_AGENT
#define LDS_WAIT() asm volatile("s_waitcnt lgkmcnt(0)" ::: "memory")
#define VM_WAIT() asm volatile("s_waitcnt vmcnt(0)" ::: "memory")
typedef float f32x2_t __attribute__((ext_vector_type(2))); typedef __bf16 bf16x2_t __attribute__((ext_vector_type(2)));
__device__ __forceinline__ unsigned pk2(float lo, float hi) { f32x2_t v = {lo, hi}; bf16x2_t b = __builtin_convertvector(v, bf16x2_t); return __builtin_bit_cast(unsigned, b); }
__device__ __forceinline__ bf16 f2bf(float f) { return (bf16)(pk2(f, 0.f) & 0xffffu); }
__device__ __forceinline__ float bf2f(bf16 b) { return __builtin_bit_cast(float, (unsigned)b << 16); }
__device__ __forceinline__ float bflo(unsigned u) { return __builtin_bit_cast(float, u << 16); }
__device__ __forceinline__ float bfhi(unsigned u) { return __builtin_bit_cast(float, u & 0xffff0000u); }
__device__ __forceinline__ float fast_sigmoid(float x) { return __builtin_amdgcn_rcpf(1.f + __builtin_amdgcn_exp2f(-LOG2E * x)); }
__device__ __forceinline__ float silu_f(float x) { return x * fast_sigmoid(x); }
__device__ __forceinline__ float gelu_tanh_f(float x) { const float u = 0.7978845608028654f * (x + 0.044715f * x * x * x); return x * fast_sigmoid(2.f * u); }
__device__ __forceinline__ int crow(int r, int hi) { return (r & 3) + 8 * (r >> 2) + 4 * hi; }
__device__ __forceinline__ float wave_sum(float v) {
#pragma unroll
    for (int o = 1; o < 64; o <<= 1) v += __shfl_xor(v, o);
    return v;
}

#define XB_TMO      128
#define XB_XCNT(j)  (256  + 64 * (j))
#define XB_XSUB(j)  (1280 + 64 * (j))
#define XB_XGEN(j)  (2304 + 64 * (j))
#define XB_TOP      3328
#define XB_TOPGEN   3392
#define XCD_BAR_WORDS 3456
#define XB_SPIN_CAP (1u << 18)
__device__ __forceinline__ unsigned xb_ld(unsigned* p)              { return __hip_atomic_load(p, __ATOMIC_RELAXED, __HIP_MEMORY_SCOPE_AGENT); }
__device__ __forceinline__ unsigned xb_add(unsigned* p, unsigned v) { return __hip_atomic_fetch_add(p, v, __ATOMIC_RELAXED, __HIP_MEMORY_SCOPE_AGENT); }
__device__ __forceinline__ unsigned xb_xcc_id() { return (unsigned)__builtin_amdgcn_s_getreg((3 << 11) | 20) & 0xFu; }
#define XB_SPIN(cond, bar) do { unsigned _sp = 0; while (cond) { __builtin_amdgcn_s_sleep(1); \
    if ((++_sp & 255u) == 0u) { if (xb_ld(&(bar)[XB_TMO])) break; if (_sp > XB_SPIN_CAP) { atomicAdd(&(bar)[XB_TMO], 1u); break; } } } } while (0)
struct XcdBarrier { unsigned* bar; unsigned x; volatile LAS unsigned* st; };
__device__ __forceinline__ XcdBarrier xcd_barrier_post(unsigned* bar, volatile LAS unsigned* st) {
    XcdBarrier b; b.bar = bar; b.x = xb_xcc_id(); b.st = st;
    if (threadIdx.x == 0) (void)xb_add(&bar[XB_XCNT(b.x)], 1u);
    return b;
}
__device__ __forceinline__ void xcd_barrier_complete(unsigned* bar, unsigned x, unsigned& nloc, unsigned& nx) {
    const unsigned G = gridDim.x * gridDim.y * gridDim.z;
    unsigned sum, cnt, mine, sp = 0u;
    for (;;) {
        sum = 0u; cnt = 0u; mine = 0u;
#pragma unroll
        for (unsigned j = 0; j < 16; ++j) { const unsigned c = xb_ld(&bar[XB_XCNT(j)]); sum += c; cnt += (c > 0u) ? 1u : 0u; mine = (j == x) ? c : mine; }
        if (sum == G) break;
        __builtin_amdgcn_s_sleep(1);
        if ((++sp & 255u) == 0u) { if (xb_ld(&bar[XB_TMO])) break; if (sp > XB_SPIN_CAP) { atomicAdd(&bar[XB_TMO], 1u); break; } }
    }
    nloc = mine > 0u ? mine : 1u; nx = cnt > 0u ? cnt : 1u;
}
__device__ __forceinline__ void xcd_barrier(const XcdBarrier& b) {
    asm volatile("s_waitcnt vmcnt(0)" ::: "memory");
    __syncthreads();
    if (threadIdx.x == 0) {
        unsigned* bar = b.bar;
        __builtin_amdgcn_s_waitcnt(0);
        unsigned nloc = b.st[0], nx = b.st[1];
        if (nloc == 0u) { xcd_barrier_complete(bar, b.x, nloc, nx); b.st[0] = nloc; b.st[1] = nx; }
        const unsigned old = xb_add(&bar[XB_XSUB(b.x)], 1u);
        const unsigned gen = old / nloc;
        if (old + 1u == (gen + 1u) * nloc) {
            __builtin_amdgcn_fence(__ATOMIC_RELEASE, "agent");
            asm volatile("s_waitcnt vmcnt(0)" ::: "memory");
            const unsigned og = xb_add(&bar[XB_TOP], 1u);
            const unsigned tg = og / nx;
            if (og + 1u == (tg + 1u) * nx) xb_add(&bar[XB_TOPGEN], 1u);
            else XB_SPIN(xb_ld(&bar[XB_TOPGEN]) == tg, bar);
            __builtin_amdgcn_fence(__ATOMIC_ACQUIRE, "agent");
            xb_add(&bar[XB_XGEN(b.x)], 1u);
            asm volatile("s_waitcnt vmcnt(0)" ::: "memory");
        } else {
            XB_SPIN(xb_ld(&bar[XB_XGEN(b.x)]) == gen, bar);
            __builtin_amdgcn_fence(__ATOMIC_ACQUIRE, "agent");
            asm volatile("s_waitcnt vmcnt(0)" ::: "memory");
        }
    }
    __syncthreads();
}

struct Args { const float* in[27]; float* out; unsigned char* ws; int ph_lo, ph_hi, li, pad; };
struct Frame {
    LAS unsigned char* lds;
    int tid, lane, wave, G;
    unsigned char* ws; float* out;
};
enum { I_XP = 0, I_XS, I_CACHE_K, I_CACHE_V, I_STATE, I_C, I_CCTX, I_WMOD, I_BMOD, I_NORMG, I_F1IN, I_F1OUT, I_WIN, I_RPB, I_CONVW, I_CONVB, I_LRUWA, I_LRUBA, I_LRUWI, I_LRUBI, I_LRULAM,
       I_WBRA, I_WBRL, I_WOUT, I_F2IN, I_F2OUT, I_FINALG };
#define WSB(F, off) ((bf16*)((F).ws + (off)))
#define WSF(F, off) ((float*)((F).ws + (off)))

using pg8::Unit;
__device__ __forceinline__ int unit_modrow(int pm) { return pm < 16 ? 8 : ((pm - 16) >> 2); }

struct EpiSwiglu {
    static constexpr bool PERM = true, AFTER_DRAIN = false;
    bf16* O;
    __device__ __forceinline__ void operator()(const f32x4 (&acc)[2][2][4][2], const Unit& u, int wr, int wc, int fr, int fq) const {
        const int row0 = u.pm * 256 + wr * 64 + fr, col0 = u.pn * 128 + wc * 32 + 8 * fq;
#pragma unroll
        for (int ai = 0; ai < 2; ++ai)
#pragma unroll
            for (int m = 0; m < 4; ++m) {
                const f32x4 g0 = acc[ai][0][m][0], g1 = acc[ai][0][m][1], u0 = acc[ai][1][m][0], u1 = acc[ai][1][m][1];
                v4u w;
                w.x = pk2(silu_f(g0[0]) * u0[0], silu_f(g0[1]) * u0[1]); w.y = pk2(silu_f(g0[2]) * u0[2], silu_f(g0[3]) * u0[3]);
                w.z = pk2(silu_f(g1[0]) * u1[0], silu_f(g1[1]) * u1[1]); w.w = pk2(silu_f(g1[2]) * u1[2], silu_f(g1[3]) * u1[3]);
                *(v4u*)(O + (size_t)(row0 + ai * 128 + m * 16) * DFF + col0) = w;
            }
    }
};
struct EpiResid {
    static constexpr bool PERM = false, AFTER_DRAIN = false;
    const float* base_ctx; const float* base_lat; float* out; const float* gate; float coef;
    __device__ __forceinline__ void operator()(const f32x4 (&acc)[2][2][4][2], const Unit& u, int wr, int wc, int fr, int fq) const {
        const int rl0 = wr * 64 + fr, col0 = u.pn * 256 + wc * 32 + 4 * fq;
        const float* bp = (u.pm < 16 ? base_ctx + (size_t)u.pm * 256 * DM : base_lat + (size_t)(u.pm - 16) * 256 * DM) + col0;
        float* op = out + (size_t)u.pm * 256 * DM + col0;
        const float* gp = gate + (size_t)unit_modrow(u.pm) * NMODC + col0;
        f32x4 gv[2][2];
#pragma unroll
        for (int bj = 0; bj < 2; ++bj)
#pragma unroll
            for (int n = 0; n < 2; ++n) gv[bj][n] = *(const f32x4*)(gp + bj * 128 + n * 16) * coef;
#pragma unroll
        for (int ai = 0; ai < 2; ++ai)
#pragma unroll
            for (int m = 0; m < 4; ++m) { const size_t ro = (size_t)(rl0 + ai * 128 + m * 16) * DM;
#pragma unroll
                for (int bj = 0; bj < 2; ++bj)
#pragma unroll
                    for (int n = 0; n < 2; ++n) { const f32x4 b = *(const f32x4*)(bp + ro + bj * 128 + n * 16); *(f32x4*)(op + ro + bj * 128 + n * 16) = b + gv[bj][n] * acc[ai][bj][m][n]; } }
    }
};
struct EpiInProj {
    static constexpr bool PERM = true, AFTER_DRAIN = false;
    bf16 *q  , *vT, *xl  ; float *ock  ;
    __device__ __forceinline__ void operator()(const f32x4 (&acc)[2][2][4][2], const Unit& u, int wr, int wc, int fr, int fq) const {
        const int pn = u.pn, pm = u.pm;
        const int rl0 = wr * 64 + fr, lc0 = wc * 32 + 8 * fq;
        if (pn < 4) {
            const bool isq = pn < 2; const float sc = isq ? QSCALE : 1.f;
            bf16* dst = q + (isq ? (size_t)0 : (size_t)(WS_K - WS_Q) / 2) + (size_t)pm * 256 * DATT + (pn & 1) * 256 + lc0;
#pragma unroll
            for (int ai = 0; ai < 2; ++ai)
#pragma unroll
                for (int m = 0; m < 4; ++m) { const int rl = rl0 + ai * 128 + m * 16;
#pragma unroll
                    for (int bj = 0; bj < 2; ++bj) { const f32x4 v0 = acc[ai][bj][m][0] * sc, v1 = acc[ai][bj][m][1] * sc;
                        v4u w; w.x = pk2(v0[0], v0[1]); w.y = pk2(v0[2], v0[3]); w.z = pk2(v1[0], v1[1]); w.w = pk2(v1[2], v1[3]);
                        *(v4u*)(dst + (size_t)rl * DATT + bj * 128) = w;
                        if (!isq && pm < 16) { const int c = (pn & 1) * 256 + bj * 128 + lc0, hh = c >> 6, d = c & 63;
                            float* o = ock + (((size_t)pm * 8 + hh) * 256 + rl) * 64 + d; *(f32x4*)o = v0; *(f32x4*)(o + 4) = v1; } } }
        } else if (pn < 6) {
            int T, t0; bf16* vb;
            if (pm < 16) { T = TCTX; t0 = 0; vb = vT + (size_t)pm * 8 * 64 * TCTX; }
            else { const int lr = (pm - 16) * 256; T = TLAT; t0 = lr & 1023; vb = vT + VT_LAT_OFF + (size_t)(lr >> 10) * 8 * 64 * TLAT; }
#pragma unroll
            for (int ai = 0; ai < 2; ++ai)
#pragma unroll
                for (int m = 0; m < 4; ++m) { const int rl = rl0 + ai * 128 + m * 16;
#pragma unroll
                    for (int bj = 0; bj < 2; ++bj) { const f32x4 v0 = acc[ai][bj][m][0], v1 = acc[ai][bj][m][1];
                        const int c = (pn & 1) * 256 + bj * 128 + lc0;
                        bf16* p = vb + (size_t)c * T + t0 + rl;
                        p[0] = f2bf(v0[0]); p[(size_t)T] = f2bf(v0[1]); p[(size_t)2 * T] = f2bf(v0[2]); p[(size_t)3 * T] = f2bf(v0[3]);
                        p[(size_t)4 * T] = f2bf(v1[0]); p[(size_t)5 * T] = f2bf(v1[1]); p[(size_t)6 * T] = f2bf(v1[2]); p[(size_t)7 * T] = f2bf(v1[3]);
                        if (pm < 16) { const int hh = c >> 6, d = c & 63;
                            float* o = ock + (OUT_CV - OUT_CK) + (((size_t)pm * 8 + hh) * 256 + rl) * 64 + d; *(f32x4*)o = v0; *(f32x4*)(o + 4) = v1; } } }
        } else {
            const int grp = (pn - 6) >> 2;
            bf16* dst = xl + (size_t)grp * ((WS_GG - WS_XL) / 2) + (size_t)pm * 256 * DM + ((pn - 6) & 3) * 256 + lc0;
#pragma unroll
            for (int ai = 0; ai < 2; ++ai)
#pragma unroll
                for (int m = 0; m < 4; ++m) { const int rl = rl0 + ai * 128 + m * 16;
#pragma unroll
                    for (int bj = 0; bj < 2; ++bj) { f32x4 v0 = acc[ai][bj][m][0], v1 = acc[ai][bj][m][1];
                        if (grp == 1) {
#pragma unroll
                            for (int e = 0; e < 4; ++e) { v0[e] = gelu_tanh_f(v0[e]); v1[e] = gelu_tanh_f(v1[e]); }
                        } else if (grp >= 2) {
#pragma unroll
                            for (int e = 0; e < 4; ++e) { v0[e] = fast_sigmoid(v0[e]); v1[e] = fast_sigmoid(v1[e]); }
                        }
                        v4u w; w.x = pk2(v0[0], v0[1]); w.y = pk2(v0[2], v0[3]); w.z = pk2(v1[0], v1[1]); w.w = pk2(v1[2], v1[3]);
                        *(v4u*)(dst + (size_t)rl * DM + bj * 128) = w; } }
        }
    }
};
template <bool ADD> struct EpiMerge {
    static constexpr bool PERM = true, AFTER_DRAIN = false;
    const bf16* sg; bf16* mb;
    __device__ __forceinline__ void operator()(const f32x4 (&acc)[2][2][4][2], const Unit& u, int wr, int wc, int fr, int fq) const {
        const int row0 = u.pm * 256 + wr * 64 + fr, col0 = u.pn * 256 + wc * 32 + 8 * fq;
#pragma unroll
        for (int ai = 0; ai < 2; ++ai)
#pragma unroll
            for (int m = 0; m < 4; ++m)
#pragma unroll
                for (int bj = 0; bj < 2; ++bj) {
                    const size_t off = (size_t)(row0 + ai * 128 + m * 16) * DM + col0 + bj * 128;
                    const v4u s = *(const v4u*)(sg + off);
                    const f32x4 a0 = acc[ai][bj][m][0], a1 = acc[ai][bj][m][1];
                    float r[8] = {bflo(s.x) * a0[0], bfhi(s.x) * a0[1], bflo(s.y) * a0[2], bfhi(s.y) * a0[3], bflo(s.z) * a1[0], bfhi(s.z) * a1[1], bflo(s.w) * a1[2], bfhi(s.w) * a1[3]};
                    if (ADD) { const v4u o = *(const v4u*)(mb + off);
                        r[0] += bflo(o.x); r[1] += bfhi(o.x); r[2] += bflo(o.y); r[3] += bfhi(o.y); r[4] += bflo(o.z); r[5] += bfhi(o.z); r[6] += bflo(o.w); r[7] += bfhi(o.w); }
                    v4u w; w.x = pk2(r[0], r[1]); w.y = pk2(r[2], r[3]); w.z = pk2(r[4], r[5]); w.w = pk2(r[6], r[7]);
                    *(v4u*)(mb + off) = w;
                }
    }
};

__device__ __forceinline__ void p0_transpose_item(const float* W, int K, int N, bf16* WT, int ldt, int swiglu_perm, LAS float* scr, int item, int lane) {
    const int nblk = N / 32, kb = item / nblk, nb = item % nblk, k0 = 64 * kb, n0 = 32 * nb;
    int drow0 = n0;
    if (swiglu_perm) { const int half = N >> 1, isu = n0 >= half ? 1 : 0, j0 = n0 - isu * half; drow0 = (j0 >> 7) * 256 + isu * 128 + (j0 & 127); }
#pragma unroll 8
    for (int i = 0; i < 32; ++i) { const int kk = 2 * i + (lane >> 5); scr[kk * 33 + (lane & 31)] = W[(size_t)(k0 + kk) * N + n0 + (lane & 31)]; }
    LDS_WAIT(); asm volatile("" ::: "memory");
    const int c = lane & 7;
#pragma unroll
    for (int j = 0; j < 4; ++j) { const int n = (lane >> 3) + 8 * j; const LAS float* s = scr + (8 * c) * 33 + n;
        v4u o; o.x = pk2(s[0 * 33], s[1 * 33]); o.y = pk2(s[2 * 33], s[3 * 33]); o.z = pk2(s[4 * 33], s[5 * 33]); o.w = pk2(s[6 * 33], s[7 * 33]);
        *(GAS v4u*)(WT + (size_t)(drow0 + n) * ldt + k0 + 8 * c) = o; }
    LDS_WAIT(); asm volatile("" ::: "memory");
}
__device__ __forceinline__ void p0_mods_item(const float* c, const float* cctx, const float* w_mod, const float* b_mod, float* mods, LAS float* scr, int item, int lane) {
    const int cg = item >> 3, kc = item & 7, n = cg * 64 + lane, k0 = kc * 128;
#pragma unroll
    for (int r = 0; r < 9; ++r)
#pragma unroll
        for (int hf = 0; hf < 2; ++hf) { const int kk = lane + 64 * hf; const float cv = (r < 8) ? c[r * DM + k0 + kk] : cctx[k0 + kk]; scr[r * 128 + kk] = silu_f(cv); }
    LDS_WAIT(); asm volatile("" ::: "memory");
    float acc[9];
#pragma unroll
    for (int r = 0; r < 9; ++r) acc[r] = 0.f;
    const float* wp = w_mod + (size_t)k0 * NMODC + n;
#pragma unroll 4
    for (int kk = 0; kk < 128; kk += 4) {
        const float w0 = wp[(size_t)(kk + 0) * NMODC], w1 = wp[(size_t)(kk + 1) * NMODC], w2 = wp[(size_t)(kk + 2) * NMODC], w3 = wp[(size_t)(kk + 3) * NMODC];
#pragma unroll
        for (int r = 0; r < 9; ++r) { const f32x4 s = *(const LAS f32x4*)(scr + r * 128 + kk); acc[r] += s[0] * w0 + s[1] * w1 + s[2] * w2 + s[3] * w3; }
    }
    const float bm = (kc == 0) ? b_mod[n] : 0.f;
#pragma unroll
    for (int r = 0; r < 9; ++r) __hip_atomic_fetch_add(mods + (size_t)r * NMODC + n, acc[r] + bm, __ATOMIC_RELAXED, __HIP_MEMORY_SCOPE_AGENT);
    LDS_WAIT(); asm volatile("" ::: "memory");
}
__device__ __forceinline__ void p0_prep(const Frame& F, const Args& A, bool do_mods) {
    LAS float* scr = (LAS float*)(F.lds + RING_OFF + F.wave * 16384);
    const int gw = blockIdx.x * NWAVES + F.wave, NGW = F.G * NWAVES, lane = F.lane;
    constexpr int N_MODS = 144 * 8;
    constexpr int N_FIN = (DM / 64) * (NFF / 32), N_FOUT = (DFF / 64) * (DM / 32), N_WIN = (DM / 64) * (INW / 32), N_WBA = (DATT / 64) * (DM / 32), N_WBL = (DLRU / 64) * (DM / 32), N_WOUT = (DM / 64) * (DM / 32);
    constexpr int N_WL = 2 * 2 * 16 * 2;
    constexpr int N_CVT = 64 * 8;
    constexpr int N_CK = 512;
    constexpr int N_BT = 8 * 15 * 4 + 1;
    constexpr int NITEMS = N_MODS + 2 * N_FIN + 2 * N_FOUT + N_WIN + N_WBA + N_WBL + N_WOUT + N_WL + N_CVT + N_CK + N_BT;
    for (int it = gw; it < NITEMS; it += NGW) {
        int r = it;
        if (r < N_MODS) { if (do_mods) p0_mods_item(A.in[I_C], A.in[I_CCTX], A.in[I_WMOD], A.in[I_BMOD], WSF(F, WS_MODS), scr, r, lane); continue; } r -= N_MODS;
        if (r < N_FIN) { p0_transpose_item(A.in[I_F1IN], DM, NFF, WSB(F, WS_W1IN), DM, 1, scr, r, lane); continue; } r -= N_FIN;
        if (r < N_FIN) { p0_transpose_item(A.in[I_F2IN], DM, NFF, WSB(F, WS_W2IN), DM, 1, scr, r, lane); continue; } r -= N_FIN;
        if (r < N_WIN) { p0_transpose_item(A.in[I_WIN], DM, INW, WSB(F, WS_WIN), DM, 0, scr, r, lane); continue; } r -= N_WIN;
        if (r < N_FOUT) { p0_transpose_item(A.in[I_F1OUT], DFF, DM, WSB(F, WS_W1OUT), DFF, 0, scr, r, lane); continue; } r -= N_FOUT;
        if (r < N_FOUT) { p0_transpose_item(A.in[I_F2OUT], DFF, DM, WSB(F, WS_W2OUT), DFF, 0, scr, r, lane); continue; } r -= N_FOUT;
        if (r < N_WBA) { p0_transpose_item(A.in[I_WBRA], DATT, DM, WSB(F, WS_WBA), DATT, 0, scr, r, lane); continue; } r -= N_WBA;
        if (r < N_WBL) { p0_transpose_item(A.in[I_WBRL], DLRU, DM, WSB(F, WS_WBL), DLRU, 0, scr, r, lane); continue; } r -= N_WBL;
        if (r < N_WOUT) { p0_transpose_item(A.in[I_WOUT], DM, DM, WSB(F, WS_WOUT), DM, 0, scr, r, lane); continue; } r -= N_WOUT;
        if (r < N_WL) {
            const int blk = r >> 1, sub = r & 1, mat = blk >> 5, dn = blk & 31;
            const float* src = (mat == 0 ? A.in[I_LRUWA] : A.in[I_LRUWI]) + (size_t)dn * 4096;
            bf16* dst = WSB(F, WS_WL) + ((size_t)((dn >> 4) * 2 + mat) * 16 + (dn & 15)) * 4096;
            p0_transpose_item(src, 64, 64, dst, 64, 0, scr, sub, lane); continue; } r -= N_WL;
        if (r < N_CVT) { const int bh = r >> 3, sub = r & 7;
            p0_transpose_item(A.in[I_CACHE_V] + (size_t)bh * 256 * 64, 256, 64, WSB(F, WS_CVT) + (size_t)bh * 64 * 256, 256, 0, scr, sub, lane); continue; } r -= N_CVT;
        if (r < N_CK) { const float* ck = A.in[I_CACHE_K]; bf16* CK = WSB(F, WS_CK);
#pragma unroll
            for (int i = 0; i < 4; ++i) { const size_t idx = (size_t)r * 2048 + i * 512 + lane * 8; const f32x4 a = *(const f32x4*)(ck + idx), b = *(const f32x4*)(ck + idx + 4);
                v4u w; w.x = pk2(a[0], a[1]); w.y = pk2(a[2], a[3]); w.z = pk2(b[0], b[1]); w.w = pk2(b[2], b[3]); *(v4u*)(CK + idx) = w; }
            continue; } r -= N_CK;
        {
            const float* rpb = A.in[I_RPB]; float* BT = WSF(F, WS_BT);
            const int kt = r & 1, qt = (r >> 1) & 1, hd = r >> 2;
            const int qc = qt * 32 + (lane & 31), hh = lane >> 5;
            const int cs = min(max(qc - 8, 0), 48);
#pragma unroll
            for (int reg = 0; reg < 16; ++reg) { const int kcol = kt * 32 + crow(reg, hh);
                const bool inw = (kcol >= cs) && (kcol < cs + 16);
                const int dc = min(max(kcol - qc, -15), 15) + 15;
                BT[((size_t)r * 16 + reg) * 64 + lane] = (r >= 480) ? 0.f : (inw ? rpb[(size_t)(hd < 120 ? hd : 0) * 31 + dc] * LOG2E : -1e30f); }
        }
    }
}

template <int MODE> __device__ __forceinline__ void norm_phase(const Frame& F, const float* xctx, const float* xlat, const float* g, int ni, bf16* H, float* Y) {
    const int gw = blockIdx.x * NWAVES + F.wave, NGW = F.G * NWAVES, lane = F.lane;
    const float* mods = WSF(F, WS_MODS);
    constexpr int NR = 6;
    for (int row0 = gw * NR; row0 < MROWS; row0 += NGW * NR) {
        f32x4 v[NR][4];
#pragma unroll
        for (int r = 0; r < NR; ++r) { const int m = row0 + r; const f32x4* xr = (const f32x4*)((m < MCTX) ? xctx + (size_t)m * DM : xlat + (size_t)(m - MCTX) * DM) + lane;
#pragma unroll
            for (int j = 0; j < 4; ++j) v[r][j] = xr[64 * j]; }
        const int mr0 = (row0 < MCTX) ? 8 : ((row0 - MCTX) >> 10), mr5 = (row0 + NR - 1 < MCTX) ? 8 : ((row0 + NR - 1 - MCTX) >> 10);
        f32x4 gv[4], sv[4], hv[4];
#pragma unroll
        for (int j = 0; j < 4; ++j) { const int col = 4 * lane + 256 * j; gv[j] = *(const f32x4*)(g + col);
            if (MODE == 0) { const float* sh = mods + (size_t)mr0 * NMODC + (3 * ni) * DM + col; hv[j] = *(const f32x4*)sh; sv[j] = *(const f32x4*)(sh + DM); } }
        float rstd[NR];
#pragma unroll
        for (int r = 0; r < NR; ++r) { float s = 0.f;
#pragma unroll
            for (int j = 0; j < 4; ++j) s += (v[r][j][0] * v[r][j][0] + v[r][j][1] * v[r][j][1]) + (v[r][j][2] * v[r][j][2] + v[r][j][3] * v[r][j][3]);
            rstd[r] = s; }
#pragma unroll
        for (int o = 1; o < 64; o <<= 1) {
#pragma unroll
            for (int r = 0; r < NR; ++r) rstd[r] += __shfl_xor(rstd[r], o); }
#pragma unroll
        for (int r = 0; r < NR; ++r) rstd[r] = 1.0f / sqrtf(rstd[r] * (1.f / DM) + EPS);
#pragma unroll
        for (int r = 0; r < NR; ++r) { const int m = row0 + r;
            if (MODE == 0) {
                unsigned long long* o8 = (unsigned long long*)(H + (size_t)m * DM) + lane;
                if (mr0 == mr5) {
#pragma unroll
                    for (int j = 0; j < 4; ++j) { const f32x4 y = v[r][j] * rstd[r] * gv[j] * (sv[j] + 1.0f) + hv[j];
                        o8[64 * j] = (unsigned long long)pk2(y[0], y[1]) | ((unsigned long long)pk2(y[2], y[3]) << 32); }
                } else {
                    const int mr = (m < MCTX) ? 8 : ((m - MCTX) >> 10);
#pragma unroll
                    for (int j = 0; j < 4; ++j) { const float* sh = mods + (size_t)mr * NMODC + (3 * ni) * DM + 4 * lane + 256 * j;
                        const f32x4 y = v[r][j] * rstd[r] * gv[j] * (*(const f32x4*)(sh + DM) + 1.0f) + *(const f32x4*)sh;
                        o8[64 * j] = (unsigned long long)pk2(y[0], y[1]) | ((unsigned long long)pk2(y[2], y[3]) << 32); }
                }
            } else {
                f32x4* yr = (f32x4*)(Y + (size_t)m * DM) + lane;
#pragma unroll
                for (int j = 0; j < 4; ++j) yr[64 * j] = v[r][j] * rstd[r] * gv[j];
            }
        }
    }
}

__device__ __forceinline__ void conv_phase(const Frame& F, const float* conv_w, const float* conv_b) {
    const bf16* XL = WSB(F, WS_XL); bf16* XC = WSB(F, WS_H);
    const size_t nthreads = (size_t)F.G * NWAVES * 64, t0 = (size_t)blockIdx.x * NWAVES * 64 + F.tid;
    for (size_t it = t0; it < (size_t)MROWS * 128; it += nthreads) {
        const int row = (int)(it >> 7), cg = (int)(it & 127), c0 = cg * 8;
        int t, T; if (row < MCTX) { t = row & 255; T = TCTX; } else { t = (row - MCTX) & 1023; T = TLAT; }
        float acc[8];
        { const f32x4 b0 = *(const f32x4*)(conv_b + c0), b1 = *(const f32x4*)(conv_b + c0 + 4);
          acc[0] = b0[0]; acc[1] = b0[1]; acc[2] = b0[2]; acc[3] = b0[3]; acc[4] = b1[0]; acc[5] = b1[1]; acc[6] = b1[2]; acc[7] = b1[3]; }
#pragma unroll
        for (int j = 0; j < 4; ++j) { const int tt = t - 2 + j;
            if (tt >= 0 && tt < T) {
                const v4u x = *(const v4u*)(XL + (size_t)(row - 2 + j) * DM + c0);
                const f32x4 w0 = *(const f32x4*)(conv_w + j * DLRU + c0), w1 = *(const f32x4*)(conv_w + j * DLRU + c0 + 4);
                acc[0] += bflo(x.x) * w0[0]; acc[1] += bfhi(x.x) * w0[1]; acc[2] += bflo(x.y) * w0[2]; acc[3] += bfhi(x.y) * w0[3];
                acc[4] += bflo(x.z) * w1[0]; acc[5] += bfhi(x.z) * w1[1]; acc[6] += bflo(x.w) * w1[2]; acc[7] += bfhi(x.w) * w1[3]; } }
        v4u w; w.x = pk2(acc[0], acc[1]); w.y = pk2(acc[2], acc[3]); w.z = pk2(acc[4], acc[5]); w.w = pk2(acc[6], acc[7]);
        *(v4u*)(XC + (size_t)row * DM + c0) = w;
    }
}

#define MFMA16(a, b, c) __builtin_amdgcn_mfma_f32_16x16x32_bf16((a), (b), (c), 0, 0, 0)
#define MFMA32(a, b, c) __builtin_amdgcn_mfma_f32_32x32x16_bf16((a), (b), (c), 0, 0, 0)
#define LRU_GATE(pa, pi, xcv, kd, A_, B_) do { if (VAR & 4) { A_ = 0.9f + 1e-3f * (pa); B_ = (pi) * (xcv) + (kd); break; } const float r_ = fast_sigmoid(pa), i_ = fast_sigmoid(pi); A_ = __builtin_amdgcn_exp2f(r_ * (kd)); \
    B_ = __builtin_amdgcn_sqrtf(1.f - A_ * A_) * (i_ * (xcv)); } while (0)
typedef _Float16 f16x2_t __attribute__((ext_vector_type(2)));
__device__ __forceinline__ unsigned pkh2(float lo, float hi) { f16x2_t v = {(_Float16)lo, (_Float16)hi}; return __builtin_bit_cast(unsigned, v); }
__device__ __forceinline__ float h2lo(unsigned u) { return (float)__builtin_bit_cast(f16x2_t, u)[0]; }
__device__ __forceinline__ float h2hi(unsigned u) { return (float)__builtin_bit_cast(f16x2_t, u)[1]; }
constexpr int XCH_STRIDE = 80;
constexpr int LRU_NTL = 8;
template <int GS> __device__ __forceinline__ void lru_part(const Frame& F, const Args& A, int s, int n, int g, int wi, LAS float* xgrp, unsigned epoch, LAS unsigned char* stash, int lane, const int VAR) {
    const int d16 = lane & 15, q4 = lane >> 4;
    constexpr int CL = 32;
    const int rb = (s < 16) ? s * TCTX : MCTX + (s - 16) * TLAT;
    const int ch = 64 * n + 16 * g + d16;
    const int qa = d16 >> 2, sa = d16 & 3;
    const bf16* xa = WSB(F, WS_H) + (size_t)(rb + (4 * wi + qa) * CL + sa) * DM + 64 * n + 8 * q4;
    const bf16* wb = WSB(F, WS_WL) + ((size_t)n * 64 + 16 * g + d16) * 64 + 8 * q4;
    const int trow = rb + (4 * wi + q4) * CL;
    bf16* lo = WSB(F, WS_LO) + (size_t)trow * DM + ch;
    const bf16* gg = WSB(F, WS_GG) + (size_t)trow * DM + ch;
    bf16x8 X0[LRU_NTL], X1[LRU_NTL]; bf16 G4[LRU_NTL][4];
#pragma unroll
    for (int j = 0; j < LRU_NTL; ++j) { if (VAR & 8) { X0[j] = *(const bf16x8*)(xa + (size_t)(j & 1) * 8); X1[j] = *(const bf16x8*)(xa + (size_t)(j & 1) * 8 + 32); } else { X0[j] = *(const bf16x8*)(xa + (size_t)(4 * j) * DM); X1[j] = *(const bf16x8*)(xa + (size_t)(4 * j) * DM + 32); } }
#pragma unroll
    for (int j = 0; j < LRU_NTL; ++j)
#pragma unroll
        for (int r = 0; r < 4; ++r) G4[j][r] = (VAR & 2) ? (bf16)(0x3F80 + j + r) : gg[(size_t)(4 * j + r) * DM];
    bf16x8 Bid[2], Baf[2], Bif[2], Bab[2], Bib[2];
#pragma unroll
    for (int ks = 0; ks < 2; ++ks) {
#pragma unroll
        for (int j = 0; j < 8; ++j) Bid[ks][j] = (32 * ks + 8 * q4 + j == 16 * g + d16) ? (short)0x3F80 : (short)0;
        Baf[ks] = *(const bf16x8*)(wb + (size_t)(0 * 16) * 4096 + 32 * ks); Bif[ks] = *(const bf16x8*)(wb + (size_t)(1 * 16) * 4096 + 32 * ks);
        Bab[ks] = *(const bf16x8*)(wb + (size_t)(2 * 16) * 4096 + 32 * ks); Bib[ks] = *(const bf16x8*)(wb + (size_t)(3 * 16) * 4096 + 32 * ks); }
    const float baf = A.in[I_LRUBA][ch], bif = A.in[I_LRUBI][ch], bab = A.in[I_LRUBA][DLRU + ch], bib = A.in[I_LRUBI][DLRU + ch];
    const float kdf = -8.f * LOG2E * log1pf(expf(-A.in[I_LRULAM][ch])), kdb = -8.f * LOG2E * log1pf(expf(-A.in[I_LRULAM][DLRU + ch]));
    float h0f = 0.f, h0b = 0.f;
    if (s >= 16) { h0f = A.in[I_STATE][(size_t)((s - 16) * 2 + 0) * DLRU + ch]; h0b = A.in[I_STATE][(size_t)((s - 16) * 2 + 1) * DLRU + ch]; }
    const f32x4 z4 = {0.f, 0.f, 0.f, 0.f};
    LAS v4u* stf = (LAS v4u*)(stash + lane * 16);
    float Hf, Hb;
    {
        float Pf = 1.f, Qf = 0.f, Pb = 1.f, Qb = 0.f;
#pragma unroll
        for (int j = 0; j < LRU_NTL; ++j) {
            const bf16x8 a0 = X0[j], a1 = X1[j];
            f32x4 caf = MFMA16(a0, Baf[0], z4), cif = MFMA16(a0, Bif[0], z4), cab = MFMA16(a0, Bab[0], z4), cib = MFMA16(a0, Bib[0], z4), cx = MFMA16(a0, Bid[0], z4);
            caf = MFMA16(a1, Baf[1], caf); cif = MFMA16(a1, Bif[1], cif); cab = MFMA16(a1, Bab[1], cab); cib = MFMA16(a1, Bib[1], cib); cx = MFMA16(a1, Bid[1], cx);
            v4u wf, wbk;
#pragma unroll
            for (int r = 0; r < 4; ++r) { float a, b;
                LRU_GATE(caf[r] + baf, cif[r] + bif, cx[r], kdf, a, b); Qf = a * Qf + b; Pf *= a; wf[r] = pkh2(1.f - a, b);
                LRU_GATE(cab[r] + bab, cib[r] + bib, cx[r], kdb, a, b); Qb = Qb + Pb * b; Pb *= a; wbk[r] = pkh2(1.f - a, b); }
            stf[j * 128] = wf; stf[j * 128 + 64] = wbk;
        }
        float pf[4], qf_[4], pb[4], qb[4];
#pragma unroll
        for (int c = 0; c < 4; ++c) { pf[c] = __shfl(Pf, d16 + 16 * c); qf_[c] = __shfl(Qf, d16 + 16 * c); pb[c] = __shfl(Pb, d16 + 16 * c); qb[c] = __shfl(Qb, d16 + 16 * c); }
        float PFt = 1.f, QFt = 0.f, PBt = 1.f, QBt = 0.f;
#pragma unroll
        for (int c = 0; c < 4; ++c) { QFt = pf[c] * QFt + qf_[c]; PFt *= pf[c]; }
#pragma unroll
        for (int c = 3; c >= 0; --c) { QBt = pb[c] * QBt + qb[c]; PBt *= pb[c]; }
        volatile LAS float* xb = xgrp + (epoch & 1u) * (GS * XCH_STRIDE);
        volatile LAS float* xme = xb + wi * XCH_STRIDE;
        if (q4 == 0) { xme[d16 * 4 + 0] = PFt; xme[d16 * 4 + 1] = QFt; xme[d16 * 4 + 2] = PBt; xme[d16 * 4 + 3] = QBt; }
        asm volatile("s_waitcnt lgkmcnt(0)" ::: "memory");
        if (lane == 0) ((volatile LAS unsigned*)xme)[64] = epoch;
        asm volatile("s_waitcnt lgkmcnt(0)" ::: "memory");
#pragma unroll
        for (int w = 0; w < GS; ++w) { if (w != wi) { unsigned spins = 0; while (((volatile LAS unsigned*)(xb + w * XCH_STRIDE))[64] != epoch) { __builtin_amdgcn_s_sleep(1); if (++spins > (1u << 22)) break; } } }
        asm volatile("" ::: "memory");
        float cf = h0f, cb = h0b;
#pragma unroll
        for (int w = 0; w < GS; ++w) { if (w < wi) { const float p = xb[w * XCH_STRIDE + d16 * 4 + 0], q = xb[w * XCH_STRIDE + d16 * 4 + 1]; cf = p * cf + q; } }
#pragma unroll
        for (int w = GS - 1; w >= 0; --w) { if (w > wi) { const float p = xb[w * XCH_STRIDE + d16 * 4 + 2], q = xb[w * XCH_STRIDE + d16 * 4 + 3]; cb = p * cb + q; } }
        { float h = cf; Hf = h;
#pragma unroll
          for (int c = 0; c < 4; ++c) { if (c == q4) Hf = h; h = pf[c] * h + qf_[c]; } }
        { float h = cb; Hb = h;
#pragma unroll
          for (int c = 3; c >= 0; --c) { if (c == q4) Hb = h; h = pb[c] * h + qb[c]; } }
    }
    {
        float h = Hb;
#pragma unroll
        for (int j = LRU_NTL - 1; j >= 0; --j) {
            const v4u w = stf[j * 128 + 64]; f32x4 hv;
#pragma unroll
            for (int r = 3; r >= 0; --r) { h = h - h2lo(w[r]) * h + h2hi(w[r]); hv[r] = h; }
            *(LAS f32x4*)&stf[j * 128 + 64] = hv;
        }
        if (VAR == 0 && s < 16 && wi == 0 && q4 == 0) F.out[OUT_ST + (size_t)(s * 2 + 1) * DLRU + ch] = h;
    }
    {
        float h = Hf;
#pragma unroll
        for (int j = 0; j < LRU_NTL; ++j) {
            const v4u w = stf[j * 128]; const f32x4 hb4 = *(const LAS f32x4*)&stf[j * 128 + 64];
#pragma unroll
            for (int r = 0; r < 4; ++r) { h = h - h2lo(w[r]) * h + h2hi(w[r]); const bf16 yv = f2bf((h + hb4[r]) * bf2f(G4[j][r])); if (VAR & 1) asm volatile("" :: "v"(yv)); else lo[(size_t)(4 * j + r) * DM] = yv; }
        }
        if (VAR == 0 && s < 16 && wi == GS - 1 && q4 == 3) F.out[OUT_ST + (size_t)(s * 2 + 0) * DLRU + ch] = h;
    }
}

constexpr int ATT_PITCH = 144, ATT_TILE_B = 64 * ATT_PITCH, ATT_BUF_B = 2 * ATT_TILE_B;
__device__ __forceinline__ float xhalf_max(float v) { auto rr = __builtin_amdgcn_permlane32_swap(__float_as_uint(v), __float_as_uint(v), false, false); return fmaxf(__uint_as_float(rr[0]), __uint_as_float(rr[1])); }
__device__ __forceinline__ float xhalf_sum(float v) { auto rr = __builtin_amdgcn_permlane32_swap(__float_as_uint(v), __float_as_uint(v), false, false); return __uint_as_float(rr[0]) + __uint_as_float(rr[1]); }
struct AttSrc { const bf16* kp; const bf16* vp; int kpitch, vpitch; };
__device__ __forceinline__ AttSrc att_src(const Frame& F, int type, int b, int h, int krmin, int i) {
    AttSrc r;
    if (type == 0) { r.kp = WSB(F, WS_K) + (size_t)(b * TCTX + i * 64) * DATT + h * 64; r.kpitch = DATT; r.vp = WSB(F, WS_VT) + (size_t)(b * 8 + h) * 64 * TCTX + i * 64; r.vpitch = TCTX; }
    else if (i < 4) { r.kp = WSB(F, WS_CK) + ((size_t)(b * 8 + h) * 256 + i * 64) * 64; r.kpitch = 64; r.vp = WSB(F, WS_CVT) + (size_t)(b * 8 + h) * 64 * 256 + i * 64; r.vpitch = 256; }
    else { const int tok = (krmin + i - 4) * 64; r.kp = WSB(F, WS_K) + (size_t)(MCTX + b * TLAT + tok) * DATT + h * 64; r.kpitch = DATT;
           r.vp = WSB(F, WS_VT) + VT_LAT_OFF + (size_t)(b * 8 + h) * 64 * TLAT + tok; r.vpitch = TLAT; }
    return r;
}
__device__ __forceinline__ void attn_wg_unit(const Frame& F, int type, int b, int h, int r0) {
    const int tid = F.tid, lane = F.lane, wave = F.wave, r32 = lane & 31, hh = lane >> 5;
    LAS unsigned char* ring = F.lds + RING_OFF;
    const int krmin = (type == 0) ? 0 : min(max(r0 - 4, 0), 8), krmax = (type == 0) ? 0 : min(max(r0 - 1, 0), 8) + 7;
    const int NS = (type == 0) ? 4 : 4 + (krmax - krmin + 1);
    const int qr = r0 + (wave >> 1), qh = wave & 1, rs = min(max(qr - 4, 0), 8);
    const int qrow = (type == 0) ? b * TCTX + wave * 32 + r32 : MCTX + b * TLAT + qr * 64 + qh * 32 + r32;
    const float* BT = WSF(F, WS_BT);
    bf16x8 qf[4];
#pragma unroll
    for (int ks = 0; ks < 4; ++ks) qf[ks] = *(const bf16x8*)(WSB(F, WS_Q) + (size_t)qrow * DATT + h * 64 + 16 * ks + 8 * hh);
    f32x16 o0, o1;
#pragma unroll
    for (int i = 0; i < 16; ++i) { o0[i] = 0.f; o1[i] = 0.f; }
    float mrun = -1e30f, lrun = 0.f;
    const int srow = tid >> 3, schunk = tid & 7;
    const int sdst = srow * ATT_PITCH + schunk * 16;
#define ATT_BIASP(i_, act_, p0_, p1_) do { const int kr_ = krmin + (i_) - 4; act_ = (type == 0) || (i_) < 4 || (kr_ >= rs && kr_ < rs + 8); \
        const bool win_ = (type == 1) && (i_) >= 4 && act_; const size_t t0_ = win_ ? (size_t)(((h * 15 + (kr_ - qr + 7)) * 2 + qh) * 2) : (size_t)480; \
        p0_ = BT + t0_ * 1024 + lane; p1_ = win_ ? p0_ + 1024 : p0_; } while (0)
    {
        const AttSrc s0 = att_src(F, type, b, h, krmin, 0);
        const v4u kv = *(const v4u*)(s0.kp + (size_t)srow * s0.kpitch + schunk * 8), vv = *(const v4u*)(s0.vp + (size_t)srow * s0.vpitch + schunk * 8);
        *(LAS v4u*)(ring + sdst) = kv; *(LAS v4u*)(ring + ATT_TILE_B + sdst) = vv;
    }
    f32x16 bc0, bc1; bool act;
    { const float *p0, *p1; ATT_BIASP(0, act, p0, p1);
#pragma unroll
      for (int i = 0; i < 16; ++i) { bc0[i] = p0[i * 64]; bc1[i] = p1[i * 64]; } }
    __syncthreads();
    for (int i = 0; i < NS; ++i) {
        const int inx = (i + 1 < NS) ? i + 1 : i;
        const AttSrc sn = att_src(F, type, b, h, krmin, inx);
        const v4u kvn = *(const v4u*)(sn.kp + (size_t)srow * sn.kpitch + schunk * 8), vvn = *(const v4u*)(sn.vp + (size_t)srow * sn.vpitch + schunk * 8);
        f32x16 bn0, bn1; bool actn;
        { const float *p0, *p1; ATT_BIASP(inx, actn, p0, p1);
#pragma unroll
          for (int k = 0; k < 16; ++k) { bn0[k] = p0[k * 64]; bn1[k] = p1[k * 64]; } }
        asm volatile("" ::: "memory"); __builtin_amdgcn_sched_barrier(0);
        if (act) {
            const LAS unsigned char* kb = ring + (i & 1) * ATT_BUF_B + r32 * ATT_PITCH + 16 * hh;
            const LAS unsigned char* vb = ring + (i & 1) * ATT_BUF_B + ATT_TILE_B + r32 * ATT_PITCH + 8 * hh;
            f32x16 s0 = bc0, s1 = bc1;
#pragma unroll
            for (int ks = 0; ks < 4; ++ks) { const bf16x8 k0 = *(const LAS bf16x8*)(kb + 32 * ks), k1 = *(const LAS bf16x8*)(kb + 32 * ATT_PITCH + 32 * ks);
                s0 = MFMA32(k0, qf[ks], s0); s1 = MFMA32(k1, qf[ks], s1); }
            float tm = fmaxf(fmaxf(s0[0], s0[1]), fmaxf(s1[0], s1[1]));
#pragma unroll
            for (int k = 2; k < 16; k += 2) tm = fmaxf(tm, fmaxf(fmaxf(s0[k], s0[k + 1]), fmaxf(s1[k], s1[k + 1])));
            tm = xhalf_max(tm);
            const float mn = fmaxf(mrun, tm), al = __builtin_amdgcn_exp2f(mrun - mn); mrun = mn;
            float ps = 0.f;
#pragma unroll
            for (int k = 0; k < 16; ++k) { s0[k] = __builtin_amdgcn_exp2f(s0[k] - mn); s1[k] = __builtin_amdgcn_exp2f(s1[k] - mn); ps += s0[k] + s1[k]; }
            lrun = lrun * al + ps;
#pragma unroll
            for (int k = 0; k < 16; ++k) { o0[k] *= al; o1[k] *= al; }
            v4u pa, pb, pc, pd;
            pa.x = pk2(s0[0], s0[1]); pa.y = pk2(s0[2], s0[3]); pa.z = pk2(s0[4], s0[5]); pa.w = pk2(s0[6], s0[7]);
            pb.x = pk2(s0[8], s0[9]); pb.y = pk2(s0[10], s0[11]); pb.z = pk2(s0[12], s0[13]); pb.w = pk2(s0[14], s0[15]);
            pc.x = pk2(s1[0], s1[1]); pc.y = pk2(s1[2], s1[3]); pc.z = pk2(s1[4], s1[5]); pc.w = pk2(s1[6], s1[7]);
            pd.x = pk2(s1[8], s1[9]); pd.y = pk2(s1[10], s1[11]); pd.z = pk2(s1[12], s1[13]); pd.w = pk2(s1[14], s1[15]);
            const bf16x8 pf[4] = {__builtin_bit_cast(bf16x8, pa), __builtin_bit_cast(bf16x8, pb), __builtin_bit_cast(bf16x8, pc), __builtin_bit_cast(bf16x8, pd)};
#pragma unroll
            for (int st = 0; st < 4; ++st) {
                const s16x4 a0 = *(const LAS s16x4*)(vb + 32 * st), a1 = *(const LAS s16x4*)(vb + 32 * st + 16);
                const s16x4 c0 = *(const LAS s16x4*)(vb + 32 * ATT_PITCH + 32 * st), c1 = *(const LAS s16x4*)(vb + 32 * ATT_PITCH + 32 * st + 16);
                o0 = MFMA32(__builtin_shufflevector(a0, a1, 0, 1, 2, 3, 4, 5, 6, 7), pf[st], o0);
                o1 = MFMA32(__builtin_shufflevector(c0, c1, 0, 1, 2, 3, 4, 5, 6, 7), pf[st], o1);
            }
        }
        { LAS unsigned char* nb = ring + ((i + 1) & 1) * ATT_BUF_B; *(LAS v4u*)(nb + sdst) = kvn; *(LAS v4u*)(nb + ATT_TILE_B + sdst) = vvn; }
        bc0 = bn0; bc1 = bn1; act = actn;
        __syncthreads();
    }
#undef ATT_BIASP
    const float inv = 1.f / xhalf_sum(lrun);
    bf16* op = WSB(F, WS_AO) + (size_t)qrow * DATT + h * 64 + 4 * hh;
#pragma unroll
    for (int g4 = 0; g4 < 4; ++g4) {
        v2u w0, w1;
        w0.x = pk2(o0[4 * g4] * inv, o0[4 * g4 + 1] * inv); w0.y = pk2(o0[4 * g4 + 2] * inv, o0[4 * g4 + 3] * inv);
        w1.x = pk2(o1[4 * g4] * inv, o1[4 * g4 + 1] * inv); w1.y = pk2(o1[4 * g4 + 2] * inv, o1[4 * g4 + 3] * inv);
        *(v2u*)(op + 8 * g4) = w0; *(v2u*)(op + 32 + 8 * g4) = w1;
    }
}

__device__ __forceinline__ void mixing_phase(const Frame& F, const Args& A, int mask, const int VAR) {
    const int lane = F.lane, wave = F.wave;
    LAS float* xl_ = (LAS float*)(F.lds + LDSCTL_OFF + 1024);
    LAS float* xs_ = xl_ + 2 * 8 * XCH_STRIDE;
    for (int u = F.tid; u < 2 * (2 * 8 * XCH_STRIDE); u += NWAVES * 64) ((volatile LAS unsigned*)xl_)[u] = 0u;
    asm volatile("s_waitcnt lgkmcnt(0)" ::: "memory"); __syncthreads();
    if ((F.G & 7) != 0) return;
    const int G8 = F.G >> 3, xg = blockIdx.x & 7, ix = blockIdx.x >> 3;
    if (mask & 1) {
    for (int v = ix; v < 32; v += G8) { const int bh = xg * 8 + (v >> 2); attn_wg_unit(F, 1, bh >> 3, bh & 7, 4 * (v & 3)); }
    for (int v = ix; v < 32; v += G8) { const int e = v & 3; if (e == 0 || e == 3) { const int bh = xg * 16 + (v >> 2) * 2 + (e == 3 ? 1 : 0); attn_wg_unit(F, 0, bh >> 3, bh & 7, 0); } }
    }
    if (!(mask & 2)) return;
    __syncthreads();
    LAS unsigned char* stash = F.lds + RING_OFF + wave * 16384;
#ifndef PROBE_LRULOOP
#define PROBE_LRULOOP 1
#endif
    unsigned epl = 1, eps = 1;
    for (int it = 0; it < PROBE_LRULOOP; ++it) {
    { for (int v = ix; v < 64; v += G8) { const int sn = xg * 16 + (v >> 2), g = v & 3; lru_part<8>(F, A, 16 + (sn >> 4), sn & 15, g, wave, xl_, epl, stash, lane, VAR); ++epl; } }
    { const int pi = wave >> 1, wi = wave & 1;
      for (int v = ix * 4 + pi; v < 128; v += G8 * 4) { const int sn = xg * 32 + (v >> 2), g = v & 3; lru_part<2>(F, A, sn >> 4, sn & 15, g, wi, xs_ + pi * (2 * 2 * XCH_STRIDE), eps, stash, lane, VAR); ++eps; } }
    }
}

__global__ void __launch_bounds__(NWAVES * 64, 2) hybrid_fwd(Args args) {
    extern __shared__ __attribute__((aligned(16))) unsigned char lds[];
    Frame F;
    F.lds = (LAS unsigned char*)lds;
    F.tid = threadIdx.x; F.lane = F.tid & 63; F.wave = __builtin_amdgcn_readfirstlane(F.tid >> 6); F.G = gridDim.x;
    F.ws = args.ws; F.out = args.out;
    for (int u = F.tid; u < (LDS_BYTES - LDSCTL_OFF) / 4; u += NWAVES * 64) ((LAS unsigned*)(F.lds + LDSCTL_OFF))[u] = 0u;
    __syncthreads();
    volatile LAS unsigned* MISC = (volatile LAS unsigned*)(F.lds + MISC_OFF);
    XcdBarrier bar; bar.bar = (unsigned*)(F.ws + WS_CTL) + CW_BAR; bar.x = 0; bar.st = nullptr;
    const bool use_bar = (args.ph_hi - args.ph_lo) > 1;
    if (use_bar) bar = xcd_barrier_post((unsigned*)(F.ws + WS_CTL) + CW_BAR, MISC + 8);
    const int lo = args.ph_lo, hi = args.ph_hi;
#define IN(k) (lo <= (k) && (k) < hi)
#define SEAM(k) do { if ((k) + 1 < hi) xcd_barrier(bar); } while (0)
    float* const xres = F.out + OUT_Y;
    float* const xres_lat = xres + (size_t)MCTX * DM;

#ifndef PROBE_PH
#define PROBE_PH (-1)
#endif
#ifndef PROBE_REPS
#define PROBE_REPS 1
#endif
#define RUNPH(k, ...) do { if (IN(k)) { { const int rep_ = 0; (void)rep_; __VA_ARGS__ } \
    if ((k) == PROBE_PH && PROBE_REPS >= 2) { xcd_barrier(bar); { const int rep_ = 1; (void)rep_; __VA_ARGS__ } } \
    if ((k) == PROBE_PH && PROBE_REPS >= 3) { xcd_barrier(bar); { const int rep_ = 2; (void)rep_; __VA_ARGS__ } } SEAM(k); } } while (0)
    RUNPH(0, p0_prep(F, args, rep_ == 0););
#ifdef PROBE_BARS
    if (IN(0) && IN(1)) { for (int i_ = 0; i_ < PROBE_BARS; ++i_) xcd_barrier(bar); }
#endif
    RUNPH(1, norm_phase<0>(F, args.in[I_XP], args.in[I_XS], args.in[I_NORMG], 0, WSB(F, WS_H), nullptr););
    RUNPH(2,
        pg8::Gemm g{WSB(F, WS_H), WSB(F, WS_W1IN), MROWS, NFF, DM}; pg8::StaticOrder S; S.init(MROWS, NFF, F.G, (int)blockIdx.x);
        EpiSwiglu E{WSB(F, WS_ACT)};
        pg8::gemm_phase<EpiSwiglu, pg8::StaticOrder, true, true>(F.lds + RING_OFF, g, S, E););
    RUNPH(3,
        pg8::Gemm g{WSB(F, WS_ACT), WSB(F, WS_W1OUT), MROWS, DM, DFF}; pg8::StaticOrder S; S.init(MROWS, DM, F.G, (int)blockIdx.x);
        EpiResid E{args.in[I_XP], args.in[I_XS], xres, WSF(F, WS_MODS) + 2 * DM, 0.5f};
        pg8::gemm_phase<EpiResid, pg8::StaticOrder, true, true>(F.lds + RING_OFF, g, S, E););
    RUNPH(4, norm_phase<0>(F, xres, xres_lat, args.in[I_NORMG] + DM, 1, WSB(F, WS_H), nullptr););
    RUNPH(5,
        pg8::Gemm g{WSB(F, WS_H), WSB(F, WS_WIN), MROWS, INW, DM}; pg8::StaticOrder S; S.init(MROWS, INW, F.G, (int)blockIdx.x);
        EpiInProj E{WSB(F, WS_Q), WSB(F, WS_VT), WSB(F, WS_XL), F.out + OUT_CK};
        pg8::gemm_phase<EpiInProj, pg8::StaticOrder, true, true>(F.lds + RING_OFF, g, S, E););
    RUNPH(6, conv_phase(F, args.in[I_CONVW], args.in[I_CONVB]););
#ifndef PROBE_SUB
#define PROBE_SUB 3
#endif
#ifndef PROBE_VAR
#define PROBE_VAR 0
#endif
    RUNPH(7, mixing_phase(F, args, rep_ == 0 ? 3 : PROBE_SUB, rep_ == 0 ? 0 : PROBE_VAR););
    RUNPH(8,
        pg8::StaticOrder S; S.init(MROWS, DM, F.G, (int)blockIdx.x);
        { pg8::Gemm g{WSB(F, WS_AO), WSB(F, WS_WBA), MROWS, DM, DATT}; EpiMerge<false> E{WSB(F, WS_SGA), WSB(F, WS_H)};
          pg8::gemm_phase<EpiMerge<false>, pg8::StaticOrder, true, true>(F.lds + RING_OFF, g, S, E); }
        { pg8::Gemm g{WSB(F, WS_LO), WSB(F, WS_WBL), MROWS, DM, DLRU}; EpiMerge<true> E{WSB(F, WS_SGB), WSB(F, WS_H)};
          pg8::gemm_phase<EpiMerge<true>, pg8::StaticOrder, true, true>(F.lds + RING_OFF, g, S, E); });
    RUNPH(9,
        pg8::Gemm g{WSB(F, WS_H), WSB(F, WS_WOUT), MROWS, DM, DM}; pg8::StaticOrder S; S.init(MROWS, DM, F.G, (int)blockIdx.x);
        EpiResid E{xres, xres_lat, xres, WSF(F, WS_MODS) + 5 * DM, 1.0f};
        pg8::gemm_phase<EpiResid, pg8::StaticOrder, true, true>(F.lds + RING_OFF, g, S, E););
    RUNPH(10, norm_phase<0>(F, xres, xres_lat, args.in[I_NORMG] + 2 * DM, 2, WSB(F, WS_H), nullptr););
    RUNPH(11,
        pg8::Gemm g{WSB(F, WS_H), WSB(F, WS_W2IN), MROWS, NFF, DM}; pg8::StaticOrder S; S.init(MROWS, NFF, F.G, (int)blockIdx.x);
        EpiSwiglu E{WSB(F, WS_ACT)};
        pg8::gemm_phase<EpiSwiglu, pg8::StaticOrder, true, true>(F.lds + RING_OFF, g, S, E););
    RUNPH(12,
        pg8::Gemm g{WSB(F, WS_ACT), WSB(F, WS_W2OUT), MROWS, DM, DFF}; pg8::StaticOrder S; S.init(MROWS, DM, F.G, (int)blockIdx.x);
        EpiResid E{xres, xres_lat, xres, WSF(F, WS_MODS) + 8 * DM, 0.5f};
        pg8::gemm_phase<EpiResid, pg8::StaticOrder, true, true>(F.lds + RING_OFF, g, S, E););
    RUNPH(13, norm_phase<1>(F, xres, xres_lat, args.in[I_FINALG], 0, nullptr, xres););
#undef RUNPH
#undef IN
#undef SEAM
}

extern "C" void kernel_launch(void* const* d_in, const int* in_sizes, int n_in, void* d_out, int out_size, void* d_ws, size_t ws_size, hipStream_t stream) {
    static int grid = 0;
    if (grid == 0) {
        if (n_in != 27 || ws_size < WS_END) { fprintf(stderr, "kernel_launch: unexpected inputs (n_in %d, ws %zu)\n", n_in, ws_size); grid = -1; return; }
        int dev = 0, cus = 0, per_cu = 0;
        if (hipGetDevice(&dev) != hipSuccess || hipDeviceGetAttribute(&cus, hipDeviceAttributeMultiprocessorCount, dev) != hipSuccess) { grid = -1; return; }
        if (hipFuncSetAttribute((const void*)hybrid_fwd, hipFuncAttributeMaxDynamicSharedMemorySize, LDS_BYTES) != hipSuccess) { fprintf(stderr, "kernel_launch: hipFuncSetAttribute failed\n"); grid = -1; return; }
        if (hipOccupancyMaxActiveBlocksPerMultiprocessor(&per_cu, (const void*)hybrid_fwd, NWAVES * 64, LDS_BYTES) != hipSuccess || per_cu < 1)
            fprintf(stderr, "kernel_launch: note: occupancy query reports %d workgroups per CU\n", per_cu);
        (void)hipGetLastError();
        grid = cus;
    }
    if (grid < 0) return;
    if (hipMemsetAsync((char*)d_ws + WS_CTL, 0, CTL_ZERO_BYTES, stream) != hipSuccess) { fprintf(stderr, "kernel_launch: memset failed\n"); return; }
    Args a{};
    for (int i = 0; i < 27; ++i) a.in[i] = (const float*)d_in[i];
    a.out = (float*)d_out; a.ws = (unsigned char*)d_ws;
    constexpr int NL = MK_N_LAUNCHES;
    for (int li = 0; li < NL; ++li) {
        a.ph_lo = (NL == 1) ? 0 : li; a.ph_hi = (NL == 1) ? NPH : li + 1; a.li = 0;
        hipLaunchKernelGGL(hybrid_fwd, dim3(grid), dim3(NWAVES * 64), LDS_BYTES, stream, a);
        const hipError_t le = hipPeekAtLastError();
        if (le != hipSuccess) { fprintf(stderr, "kernel_launch: launch %d failed: %s\n", li, hipGetErrorName(le)); break; }
    }
}
```
